# Optimizing an MI355X kernel written in HIP

```python
import math
import jax, jax.numpy as jnp
from jax import lax
import numpy as np

D_MODEL = 4096
BATCH = 1
SEQ = 8192
DEPTH = 1
DEC_BATCH = 32
DEC_SEQ = 8
PAST_LEN = 8192
PAGE_SIZE = 128

D_MIX = D_MODEL
ATTN_WIDTH = D_MIX // 2
POOL_WIDTH = D_MIX - ATTN_WIDTH
HEAD_DIM = 128
N_HEADS = ATTN_WIDTH // HEAD_DIM
N_KV_HEADS = max(1, N_HEADS // 4)
KV_GROUP = N_HEADS // N_KV_HEADS
KV_WIDTH = N_KV_HEADS * HEAD_DIM
ATTN_SCALE = HEAD_DIM ** -0.5
MOBA_BLOCK = 256
MOBA_TOPK = 3
Q_CHUNK = 16
POOL_WINDOWS = (2, 4, 8, 16)
N_POOL_GROUPS = len(POOL_WINDOWS)
POOL_GROUP_WIDTH = POOL_WIDTH // N_POOL_GROUPS
POOL_HIST = max(POOL_WINDOWS) - 1
NUM_BUCKETS = 32
MAX_EXACT = NUM_BUCKETS // 2
MAX_DISTANCE = 4096
RMS_EPS = 1e-6
NEG_INF = -1e30
IN_WIDTH = 2 * ATTN_WIDTH + 2 * KV_WIDTH + 2 * POOL_WIDTH
SPLITS = (ATTN_WIDTH, ATTN_WIDTH + KV_WIDTH, ATTN_WIDTH + 2 * KV_WIDTH,
          2 * ATTN_WIDTH + 2 * KV_WIDTH, 2 * ATTN_WIDTH + 2 * KV_WIDTH + POOL_WIDTH)

kernel_name = "moba_pool_hybrid_step"


def rms_norm(x, gain):
    xf = x.astype(jnp.float32)
    y = xf * lax.rsqrt(jnp.mean(xf * xf, axis=-1, keepdims=True) + RMS_EPS)
    return (y * gain.astype(jnp.float32)).astype(x.dtype)


def rel_bucket(dist):
    n = jnp.maximum(dist, 0)
    nf = jnp.maximum(n, 1).astype(jnp.float32)
    large = MAX_EXACT + (jnp.log(nf / MAX_EXACT) / math.log(MAX_DISTANCE / MAX_EXACT)
                         * (NUM_BUCKETS - MAX_EXACT)).astype(jnp.int32)
    large = jnp.minimum(large, NUM_BUCKETS - 1)
    return jnp.where(n < MAX_EXACT, n, large)


def ceil_blocks(length):
    return -(-length // MOBA_BLOCK) * MOBA_BLOCK


def pad_rows(x, length, axis):
    pad = [(0, 0)] * x.ndim
    pad[axis] = (0, length - x.shape[axis])
    return jnp.pad(x, pad)


def project(h, gain, w):
    n, t, _ = h.shape
    z = rms_norm(h, gain) @ w
    q, k, v, g_attn, u, g_pool = jnp.split(z, list(SPLITS), axis=-1)
    return (q.reshape(n, t, N_HEADS, HEAD_DIM),
            k.reshape(n, t, N_KV_HEADS, HEAD_DIM),
            v.reshape(n, t, N_KV_HEADS, HEAD_DIM),
            g_attn, u, g_pool)


def moba_chunk(qc, pc, bc, vc, k_full, v_full, rel_bias):
    kp = bc[..., None] * MOBA_BLOCK + jnp.arange(MOBA_BLOCK, dtype=jnp.int32)
    kvh = (jnp.arange(N_HEADS) // KV_GROUP)[None, :, None, None]
    kg = k_full[kp, kvh]
    vg = v_full[kp, kvh]
    logits = jnp.einsum('chd,chjkd->chjk', qc, kg).astype(jnp.float32) * ATTN_SCALE
    dist = pc[:, None, None, None] - kp
    hidx = jnp.arange(N_HEADS)[None, :, None, None]
    logits = logits + rel_bias[rel_bucket(dist), hidx].astype(jnp.float32)
    valid = vc[:, None, :, None] & (dist >= 0)
    logits = jnp.where(valid, logits, NEG_INF)
    c, h, j, b = logits.shape
    p = jax.nn.softmax(logits.reshape(c, h, j * b), axis=-1).reshape(c, h, j, b)
    return jnp.einsum('chjk,chjkd->chd', p.astype(vg.dtype), vg)


def moba_sequence(q, k_full, v_full, pos, rel_bias, q_chunk):
    n_q = q.shape[0]
    n_blk = k_full.shape[0] // MOBA_BLOCK
    kvh = jnp.arange(N_HEADS) // KV_GROUP
    k_mean = k_full.astype(jnp.float32).reshape(
        n_blk, MOBA_BLOCK, N_KV_HEADS, HEAD_DIM).mean(axis=1)[:, kvh]
    n_past = pos // MOBA_BLOCK
    gate = jnp.einsum('qhd,nhd->qhn', q.astype(jnp.float32), k_mean)
    gate = jnp.where(jnp.arange(n_blk)[None, None, :] < n_past[:, None, None], gate, NEG_INF)
    k_sel = min(MOBA_TOPK, n_blk)
    _, sel = lax.top_k(gate, k_sel)
    own = jnp.broadcast_to(n_past[:, None, None], (n_q, N_HEADS, 1)).astype(sel.dtype)
    blocks = jnp.concatenate([sel, own], axis=-1)
    n_j = k_sel + 1
    blk_valid = jnp.concatenate(
        [jnp.arange(k_sel)[None, :] < n_past[:, None], jnp.ones((n_q, 1), dtype=bool)], axis=-1)
    n_c = n_q // q_chunk
    xs = (q.reshape(n_c, q_chunk, N_HEADS, HEAD_DIM), pos.reshape(n_c, q_chunk),
          blocks.reshape(n_c, q_chunk, N_HEADS, n_j), blk_valid.reshape(n_c, q_chunk, n_j))
    out = lax.map(lambda a: moba_chunk(a[0], a[1], a[2], a[3], k_full, v_full, rel_bias), xs)
    return out.reshape(n_q, N_HEADS, HEAD_DIM)


def pool_mixer(u_ext, pos, w_pool, pool_scale):
    n, total, _ = u_ext.shape
    t = total - POOL_HIST
    cs = jnp.concatenate([jnp.zeros((n, 1, POOL_WIDTH), jnp.float32),
                          jnp.cumsum(u_ext, axis=1)], axis=1)
    u_new = u_ext[:, POOL_HIST:]
    parts = []
    for g, w in enumerate(POOL_WINDOWS):
        sl = slice(g * POOL_GROUP_WIDTH, (g + 1) * POOL_GROUP_WIDTH)
        win_sum = (cs[:, POOL_HIST + 1:POOL_HIST + 1 + t, sl]
                   - cs[:, POOL_HIST + 1 - w:POOL_HIST + 1 - w + t, sl])
        count = jnp.minimum(w, pos + 1).astype(jnp.float32)
        parts.append(win_sum / count[None, :, None] - u_new[..., sl])
    z = jnp.stack(parts, axis=2)
    y = jnp.einsum('ntgc,gcd->ntgd', z, w_pool.astype(jnp.float32))
    return y.reshape(n, t, POOL_WIDTH) * pool_scale.astype(jnp.float32)


def merge(h, attn, g_attn, pooled, g_pool, w):
    n, t, _ = h.shape
    y_a = attn.reshape(n, t, ATTN_WIDTH) * jax.nn.silu(g_attn)
    y_p = pooled.astype(h.dtype) * jax.nn.silu(g_pool)
    return h + jnp.concatenate([y_a, y_p], axis=-1) @ w


def setup_inputs(seed: int = 0) -> dict:
    key = jax.random.key(seed)
    ks = jax.random.split(key, 13)
    n_pages = PAST_LEN // PAGE_SIZE
    n_used = DEC_BATCH * n_pages
    n_phys = n_used + (n_used + 3) // 4
    nrm = lambda k, shape: jax.random.normal(k, shape, jnp.float32)
    return {
        "x_prompt": nrm(ks[0], (BATCH, SEQ, D_MODEL)),
        "x_sample": nrm(ks[1], (DEC_BATCH, DEC_SEQ, D_MODEL)),
        "cache_k": nrm(ks[2], (DEPTH, n_phys, PAGE_SIZE, N_KV_HEADS, HEAD_DIM)),
        "cache_v": nrm(ks[3], (DEPTH, n_phys, PAGE_SIZE, N_KV_HEADS, HEAD_DIM)),
        "state_pool": nrm(ks[4], (DEPTH, DEC_BATCH, POOL_HIST, POOL_WIDTH)),
        "page_table": jax.random.permutation(ks[5], n_phys)[:n_used].reshape(
            DEC_BATCH, n_pages).astype(jnp.int32),
        "norm_in": 1.0 + 0.1 * nrm(ks[6], (DEPTH, D_MODEL)),
        "w_in": nrm(ks[7], (DEPTH, D_MODEL, IN_WIDTH)) * D_MODEL ** -0.5,
        "w_pool": nrm(ks[8], (DEPTH, N_POOL_GROUPS, POOL_GROUP_WIDTH, POOL_GROUP_WIDTH))
                  * POOL_GROUP_WIDTH ** -0.5,
        "pool_scale": 1.0 + 0.1 * nrm(ks[9], (DEPTH, POOL_WIDTH)),
        "w_out": nrm(ks[10], (DEPTH, D_MIX, D_MODEL)) * D_MIX ** -0.5,
        "rel_bias": 0.5 * nrm(ks[11], (NUM_BUCKETS, N_HEADS)),
        "norm_out": 1.0 + 0.1 * nrm(ks[12], (D_MODEL,)),
    }


def reference(x_prompt, x_sample, cache_k, cache_v, state_pool, page_table,
              norm_in, w_in, w_pool, pool_scale, w_out, rel_bias, norm_out):
    pos_p = jnp.arange(SEQ, dtype=jnp.int32)
    pos_s = PAST_LEN + jnp.arange(DEC_SEQ, dtype=jnp.int32)
    len_p = ceil_blocks(SEQ)
    len_s = ceil_blocks(PAST_LEN + DEC_SEQ)
    h_p, h_s = x_prompt, x_sample
    kp_l, vp_l, pp_l, ks_l, vs_l, ps_l = [], [], [], [], [], []
    for layer in range(DEPTH):
        q, k, v, g_a, u, g_p = project(h_p, norm_in[layer], w_in[layer])
        k_pad = pad_rows(k, len_p, 1)
        v_pad = pad_rows(v, len_p, 1)
        attn = lax.map(lambda a: moba_sequence(a[0], a[1], a[2], pos_p, rel_bias, Q_CHUNK),
                       (q, k_pad, v_pad))
        u_ext = jnp.concatenate([jnp.zeros((BATCH, POOL_HIST, POOL_WIDTH), jnp.float32),
                                 u.astype(jnp.float32)], axis=1)
        pooled = pool_mixer(u_ext, pos_p, w_pool[layer], pool_scale[layer])
        h_p = merge(h_p, attn, g_a, pooled, g_p, w_out[layer])
        kp_l.append(k)
        vp_l.append(v)
        pp_l.append(u_ext[:, -POOL_HIST:].astype(x_prompt.dtype))
        q, k, v, g_a, u, g_p = project(h_s, norm_in[layer], w_in[layer])
        ck = cache_k[layer]
        cv = cache_v[layer]

        def attend_one(a, ck=ck, cv=cv):
            qb, kb, vb, pt = a
            k_full = jnp.concatenate([ck[pt].reshape(-1, N_KV_HEADS, HEAD_DIM), kb], axis=0)
            v_full = jnp.concatenate([cv[pt].reshape(-1, N_KV_HEADS, HEAD_DIM), vb], axis=0)
            return moba_sequence(qb, pad_rows(k_full, len_s, 0), pad_rows(v_full, len_s, 0),
                                 pos_s, rel_bias, DEC_SEQ)

        attn = lax.map(attend_one, (q, k, v, page_table))
        u_ext = jnp.concatenate([state_pool[layer].astype(jnp.float32),
                                 u.astype(jnp.float32)], axis=1)
        pooled = pool_mixer(u_ext, pos_s, w_pool[layer], pool_scale[layer])
        h_s = merge(h_s, attn, g_a, pooled, g_p, w_out[layer])
        ks_l.append(k)
        vs_l.append(v)
        ps_l.append(u_ext[:, -POOL_HIST:].astype(state_pool.dtype))
    y_prompt = rms_norm(h_p, norm_out)
    y_sample = rms_norm(h_s, norm_out)
    k_prompt = jnp.stack(kp_l)
    v_prompt = jnp.stack(vp_l)
    pool_prompt = jnp.stack(pp_l)
    k_sample = jnp.stack(ks_l)
    v_sample = jnp.stack(vs_l)
    pool_sample = jnp.stack(ps_l)
    return (y_prompt, y_sample, k_prompt, v_prompt, pool_prompt, k_sample, v_sample, pool_sample)
```

```cpp
#include <hip/hip_runtime.h>
#include <cstdio>
#include <cstdint>

#ifndef MK_N_LAUNCHES
#define MK_N_LAUNCHES 1
#endif

#define GAS __attribute__((address_space(1)))
#define LAS __attribute__((address_space(3)))
typedef unsigned short bf16;
typedef unsigned v4u __attribute__((ext_vector_type(4)));
typedef unsigned v2u __attribute__((ext_vector_type(2)));
typedef float f32x4 __attribute__((ext_vector_type(4)));
typedef float f32x2 __attribute__((ext_vector_type(2)));
typedef float f32x16 __attribute__((ext_vector_type(16)));
typedef short bf16x8 __attribute__((ext_vector_type(8)));
typedef short s16x4 __attribute__((ext_vector_type(4)));

constexpr int MP = 8192, MS = 256, MT = MP + MS, DM = 4096, NIN = 9216, AW = 2048, KVW = 512, PW = 2048, NH = 16;
constexpr float LOG2E = 1.4426950408889634f;
constexpr float C_SC = 0.08838834764831845f * LOG2E;
constexpr float RMS_EPS = 1e-6f;
constexpr size_t O_Y = 0, O_KP = (size_t)MT * DM, O_VP = O_KP + (size_t)MP * KVW, O_PP = O_VP + (size_t)MP * KVW, O_KS = O_PP + 15 * PW, O_VS = O_KS + (size_t)MS * KVW,
                 O_PS = O_VS + (size_t)MS * KVW, O_END = O_PS + (size_t)32 * 15 * PW;
constexpr size_t MiB = 1u << 20;
constexpr size_t WS_CTL = 0, CTL_ZERO_BYTES = 1 * MiB;
constexpr size_t WS_WIN = 1 * MiB, WS_WOUT = 73 * MiB, WS_WP = 105 * MiB, WS_XN = 107 * MiB, WS_Q = 173 * MiB, WS_GA = 206 * MiB, WS_U = 239 * MiB, WS_GP = 272 * MiB, WS_ZP = 305 * MiB,
                 WS_K = 338 * MiB, WS_V = 347 * MiB, WS_MIX = 356 * MiB, WS_CMEAN = 422 * MiB, WS_LP = 424 * MiB, WS_LS = 440 * MiB, WS_PO = 441 * MiB, WS_PL = 540 * MiB, WS_SSQ = 542 * MiB,
                 WS_END = 545 * MiB;
constexpr int CW_TMO = 0, CW_BAR = 4096, CW_CNTP = 8192, CW_CNTS = 8448, CW_KMS = 16384;
constexpr int LP_CAP = 32768;
constexpr int RING_BYTES = 131072, LDSCTL_OFF = RING_BYTES, LDS_BYTES = 147456;
constexpr int ATT_KV = 0, ATT_TAB = 65536, TABN = 3104, TAB_NEG = 128, ATT_WS = ATT_TAB + 4 * TABN * 4  , ATT_PREF = ATT_WS + 8 * 256  ;
static_assert(ATT_PREF + 132 * 4 <= RING_BYTES, "attention LDS map");

#define LDS_WAIT() asm volatile("s_waitcnt lgkmcnt(0)" ::: "memory")
#define VM_WAIT() asm volatile("s_waitcnt vmcnt(0)" ::: "memory")
__device__ __forceinline__ unsigned cvt_pk_bf16(float lo, float hi) { unsigned r; asm volatile("v_cvt_pk_bf16_f32 %0, %1, %2" : "=v"(r) : "v"(lo), "v"(hi)); return r; }
__device__ __forceinline__ float bf2f(unsigned short b) { return __uint_as_float(((unsigned)b) << 16); }
__device__ __forceinline__ float bflo(unsigned w) { return __uint_as_float(w << 16); }
__device__ __forceinline__ float bfhi(unsigned w) { return __uint_as_float(w & 0xffff0000u); }
__device__ __forceinline__ float silu_f(float x) { return x * __builtin_amdgcn_rcpf(1.0f + __builtin_amdgcn_exp2f(-x * LOG2E)); }
__device__ __forceinline__ float wave_sum(float v) {
#pragma unroll
    for (int o = 1; o < 64; o <<= 1) v += __shfl_xor(v, o);
    return v;
}

namespace pg8 {
#define PG8_LAS __attribute__((address_space(3)))
typedef unsigned short bf16_t;
constexpr int BM = 256, BK = 64, HALF = 128, HTB = HALF * BK * 2, STAGE_BYTES = 8 * HTB, NXCD = 8, WGM = 8;
__host__ __device__ __forceinline__ int lds_byte(int r, int c) { const int st = (r >> 4) * 2 + (c >> 5), rr = r & 15, cc = c & 31, ob = rr * 64 + cc * 2; return st * 1024 + (ob ^ (((ob >> 9) & 1) << 5)); }
__host__ __device__ __forceinline__ void stage_rc(int b, int& R, int& C) { const int st = b / 1024, sb = b % 1024, swz = sb ^ (((sb >> 9) & 1) << 5); R = (st >> 1) * 16 + swz / 64; C = (st & 1) * 32 + (swz % 64) / 2; }
__host__ __device__ __forceinline__ int perm32(int rho) { const int n = rho >> 4, i = rho & 15; return 8 * (i >> 2) + 4 * n + (i & 3); }
struct Unit { int pm, pn; };
struct Gemm { const bf16_t* A; const bf16_t* Bt; int M, N, K, lda, ldb, grp_shift, grp_acol; };
struct StaticOrder {
    int nM, nN, nwg, G, c;
    __device__ void init(int M, int N, int G_, int c_) { nM = M / BM; nN = N / BM; nwg = nM * nN; G = G_; c = c_; }
    __device__ bool next(int i, Unit& u) const {
        const long L = (long)i * G + c; if (L >= nwg) return false;
        int wgid = (int)L; { const int q = nwg / NXCD, r = nwg % NXCD, xcd = wgid % NXCD, off = wgid / NXCD; wgid = (xcd < r ? xcd * (q + 1) : r * (q + 1) + (xcd - r) * q) + off; }
        const int nig = WGM * nN, gid = wgid / nig, fm = gid * WGM, gsz = (nM - fm) < WGM ? (nM - fm) : WGM;
        u.pm = fm + ((wgid % nig) % gsz); u.pn = (wgid % nig) / gsz; return true;
    }
};
template <class Epi>
__device__ __forceinline__ void gemm_phase(PG8_LAS unsigned char* lds, const Gemm g, const StaticOrder& S, const Epi& E) {
    const int tid = threadIdx.x, wid = __builtin_amdgcn_readfirstlane(tid >> 6), lane = tid & 63, wr = wid >> 2, wc = wid & 3, fr = lane & 15, fq = lane >> 4;
    const int K = g.K, nt = K / BK;
    unsigned voffA[2], voffB[2];
#pragma unroll
    for (int i = 0; i < 2; ++i) { int R, C; stage_rc(tid * 16 + i * 8192, R, C); const int Rb = (R & ~31) + perm32(R & 31);
        voffA[i] = (unsigned)(R * g.lda + C) * 2u; voffB[i] = (unsigned)(Rb * g.ldb + C) * 2u; }
    const size_t kstep = (size_t)(BK * 2);
    const size_t hstepA = (size_t)HALF * g.lda * 2, hstepB = (size_t)HALF * g.ldb * 2;
    const size_t tstepA = 2 * hstepA, tstepB = 2 * hstepB;
    const unsigned ldsw = (unsigned)wid * 1024u;
    const int aoff = lds_byte(wr * 64 + fr, fq * 8), boff = lds_byte(wc * 32 + fr, fq * 8);
#define PG8_SA(b, h) (((b) * 2 + (h)) * HTB)
#define PG8_SB(b, h) ((4 + (b) * 2 + (h)) * HTB)
#define PG8_STAGE(bufoff, gbase, voff) do { _Pragma("unroll") for (int _i = 0; _i < 2; ++_i) \
        __builtin_amdgcn_global_load_lds((const unsigned*)((const char*)(gbase) + (voff)[_i]), (PG8_LAS unsigned*)(lds + (bufoff) + ldsw + _i * 8192), 16, 0, 0); } while (0)
#define PG8_LDA(dst, b, h) do { _Pragma("unroll") for (int m = 0; m < 4; ++m) _Pragma("unroll") for (int k = 0; k < 2; ++k) dst[m][k] = *(const PG8_LAS bf16x8*)(lds + PG8_SA(b, h) + aoff + m * 2048 + k * 1024); } while (0)
#define PG8_LDB(dst, b, h) do { _Pragma("unroll") for (int n = 0; n < 2; ++n) _Pragma("unroll") for (int k = 0; k < 2; ++k) dst[n][k] = *(const PG8_LAS bf16x8*)(lds + PG8_SB(b, h) + boff + n * 2048 + k * 1024); } while (0)
#define PG8_MMA(ai, bj, At, Bt) do { __builtin_amdgcn_s_setprio(1); _Pragma("unroll") for (int m = 0; m < 4; ++m) _Pragma("unroll") for (int n = 0; n < 2; ++n) _Pragma("unroll") for (int k = 0; k < 2; ++k) \
        acc[ai][bj][m][n] = __builtin_amdgcn_mfma_f32_16x16x32_bf16(Bt[n][k], At[m][k], acc[ai][bj][m][n], 0, 0, 0); __builtin_amdgcn_s_setprio(0); } while (0)
#define PG8_WAIT_V(n) asm volatile("s_waitcnt vmcnt(" #n ")" ::: "memory")
#define PG8_WAIT_L(n) asm volatile("s_waitcnt lgkmcnt(" #n ")" ::: "memory")
#define PG8_BAR __builtin_amdgcn_s_barrier()
#define PG8_SCHED __builtin_amdgcn_sched_barrier(0)
#define PG8_APTR(u) ((const char*)g.A + (size_t)(u).pm * tstepA + (size_t)(((u).pn >> g.grp_shift) * g.grp_acol) * 2)
#define PG8_BPTR(u) ((const char*)g.Bt + (size_t)(u).pn * tstepB)
    Unit cur, nxt; int ui = 0;
    if (!S.next(0, cur)) return;
    f32x4 acc[2][2][4][2];
#pragma unroll
    for (int a = 0; a < 2; ++a)
#pragma unroll
        for (int b = 0; b < 2; ++b)
#pragma unroll
            for (int m = 0; m < 4; ++m)
#pragma unroll
                for (int n = 0; n < 2; ++n) acc[a][b][m][n] = (f32x4){0.f, 0.f, 0.f, 0.f};
    bf16x8 At[4][2], B0[2][2], B1[2][2];
    const char* cA = PG8_APTR(cur); const char* cB = PG8_BPTR(cur);
    PG8_STAGE(PG8_SB(0, 0), cB, voffB); PG8_STAGE(PG8_SB(0, 1), cB + hstepB, voffB); PG8_STAGE(PG8_SA(0, 0), cA, voffA); PG8_STAGE(PG8_SA(0, 1), cA + hstepA, voffA);
    if (wr == 1) PG8_BAR;
    PG8_WAIT_V(2); PG8_BAR;
    PG8_STAGE(PG8_SB(1, 0), cB + kstep, voffB); PG8_STAGE(PG8_SA(1, 0), cA + kstep, voffA); PG8_STAGE(PG8_SB(1, 1), cB + hstepB + kstep, voffB);
    PG8_WAIT_V(6); PG8_BAR;
    for (;;) {
        const bool has_next = S.next(ui + 1, nxt);
        const char* nA = has_next ? PG8_APTR(nxt) : cA; const char* nB = has_next ? PG8_BPTR(nxt) : cB;
        for (int t = 0; t < nt; t += 2) {
            const bool last = (t == nt - 2);
            const char* a1 = cA + (size_t)(t + 1) * kstep;
            const char* a2 = last ? nA : cA + (size_t)(t + 2) * kstep; const char* b2 = last ? nB : cB + (size_t)(t + 2) * kstep;
            const char* a3 = a2 + kstep; const char* b3 = b2 + kstep;
            PG8_LDB(B0, 0, 0); PG8_LDB(B1, 0, 1); PG8_SCHED; PG8_LDA(At, 0, 0); PG8_STAGE(PG8_SA(1, 1), a1 + hstepA, voffA);
            PG8_WAIT_V(8); PG8_WAIT_L(0); PG8_BAR; PG8_MMA(0, 0, At, B0); PG8_MMA(0, 1, At, B1); PG8_BAR; PG8_SCHED;
            PG8_LDA(At, 0, 1); PG8_STAGE(PG8_SB(0, 0), b2, voffB); PG8_STAGE(PG8_SB(0, 1), b2 + hstepB, voffB); PG8_STAGE(PG8_SA(0, 0), a2, voffA);
            PG8_WAIT_V(8); PG8_WAIT_L(0); PG8_BAR; PG8_MMA(1, 0, At, B0); PG8_MMA(1, 1, At, B1); PG8_BAR; PG8_SCHED;
            PG8_LDB(B0, 1, 0); PG8_LDB(B1, 1, 1); PG8_SCHED; PG8_LDA(At, 1, 0); PG8_STAGE(PG8_SA(0, 1), a2 + hstepA, voffA);
            PG8_WAIT_V(8); PG8_WAIT_L(0); PG8_BAR; PG8_MMA(0, 0, At, B0); PG8_MMA(0, 1, At, B1); PG8_BAR; PG8_SCHED;
            PG8_LDA(At, 1, 1); PG8_STAGE(PG8_SB(1, 0), b3, voffB); PG8_STAGE(PG8_SB(1, 1), b3 + hstepB, voffB); PG8_STAGE(PG8_SA(1, 0), a3, voffA);
            PG8_WAIT_V(8); PG8_WAIT_L(0); PG8_BAR; PG8_MMA(1, 0, At, B0); PG8_MMA(1, 1, At, B1); PG8_BAR; PG8_SCHED;
        }
        if (wr == 0) PG8_BAR;
        E(acc, cur, wr, wc, fr, fq);
        if (!has_next) break;
#pragma unroll
        for (int a = 0; a < 2; ++a)
#pragma unroll
            for (int b = 0; b < 2; ++b)
#pragma unroll
                for (int m = 0; m < 4; ++m)
#pragma unroll
                    for (int n = 0; n < 2; ++n) acc[a][b][m][n] = (f32x4){0.f, 0.f, 0.f, 0.f};
        cur = nxt; cA = nA; cB = nB; ++ui;
        if (wr == 1) PG8_BAR;
    }
    PG8_WAIT_V(0);
    PG8_BAR;
#undef PG8_SA
#undef PG8_SB
#undef PG8_STAGE
#undef PG8_LDA
#undef PG8_LDB
#undef PG8_MMA
#undef PG8_WAIT_V
#undef PG8_WAIT_L
#undef PG8_BAR
#undef PG8_SCHED
#undef PG8_APTR
#undef PG8_BPTR
}
}

#define XB_TMO      128
#define XB_XCNT(j)  (256  + 64 * (j))
#define XB_XSUB(j)  (1280 + 64 * (j))
#define XB_XGEN(j)  (2304 + 64 * (j))
#define XB_TOP      3328
#define XB_TOPGEN   3392
#define XCD_BAR_WORDS 3456
#define XB_SPIN_CAP (1u << 18)
__device__ __forceinline__ unsigned xb_ld(unsigned* p)              { return __hip_atomic_load(p, __ATOMIC_RELAXED, __HIP_MEMORY_SCOPE_AGENT); }
__device__ __forceinline__ unsigned xb_add(unsigned* p, unsigned v) { return __hip_atomic_fetch_add(p, v, __ATOMIC_RELAXED, __HIP_MEMORY_SCOPE_AGENT); }
__device__ __forceinline__ unsigned xb_xcc_id() { return (unsigned)__builtin_amdgcn_s_getreg((3 << 11) | 20) & 0xFu; }
#define XB_SPIN(cond, bar) do { unsigned _sp = 0; while (cond) { __builtin_amdgcn_s_sleep(1); \
    if ((++_sp & 255u) == 0u) { if (xb_ld(&(bar)[XB_TMO])) break; if (_sp > XB_SPIN_CAP) { atomicAdd(&(bar)[XB_TMO], 1u); break; } } } } while (0)
struct XcdBarrier { unsigned* bar; unsigned x; volatile LAS unsigned* st; };
__device__ __forceinline__ XcdBarrier xcd_barrier_post(unsigned* bar, volatile LAS unsigned* st) {
    XcdBarrier b; b.bar = bar; b.x = xb_xcc_id(); b.st = st;
    if (threadIdx.x == 0) (void)xb_add(&bar[XB_XCNT(b.x)], 1u);
    return b;
}
__device__ __forceinline__ void xcd_barrier_complete(unsigned* bar, unsigned x, unsigned& nloc, unsigned& nx) {
    const unsigned G = gridDim.x * gridDim.y * gridDim.z;
    unsigned sum, cnt, mine, sp = 0u;
    for (;;) {
        sum = 0u; cnt = 0u; mine = 0u;
#pragma unroll
        for (unsigned j = 0; j < 16; ++j) { const unsigned c = xb_ld(&bar[XB_XCNT(j)]); sum += c; cnt += (c > 0u) ? 1u : 0u; mine = (j == x) ? c : mine; }
        if (sum == G) break;
        __builtin_amdgcn_s_sleep(1);
        if ((++sp & 255u) == 0u) { if (xb_ld(&bar[XB_TMO])) break; if (sp > XB_SPIN_CAP) { atomicAdd(&bar[XB_TMO], 1u); break; } }
    }
    nloc = mine > 0u ? mine : 1u; nx = cnt > 0u ? cnt : 1u;
}
__device__ __forceinline__ void xcd_barrier(const XcdBarrier& b) {
    asm volatile("s_waitcnt vmcnt(0)" ::: "memory");
    __syncthreads();
    if (threadIdx.x == 0) {
        unsigned* bar = b.bar;
        __builtin_amdgcn_s_waitcnt(0);
        unsigned nloc = b.st[0], nx = b.st[1];
        if (nloc == 0u) { xcd_barrier_complete(bar, b.x, nloc, nx); b.st[0] = nloc; b.st[1] = nx; }
        const unsigned old = xb_add(&bar[XB_XSUB(b.x)], 1u);
        const unsigned gen = old / nloc;
        if (old + 1u == (gen + 1u) * nloc) {
            __builtin_amdgcn_fence(__ATOMIC_RELEASE, "agent");
            asm volatile("s_waitcnt vmcnt(0)" ::: "memory");
            const unsigned og = xb_add(&bar[XB_TOP], 1u);
            const unsigned tg = og / nx;
            if (og + 1u == (tg + 1u) * nx) xb_add(&bar[XB_TOPGEN], 1u);
            else XB_SPIN(xb_ld(&bar[XB_TOPGEN]) == tg, bar);
            __builtin_amdgcn_fence(__ATOMIC_ACQUIRE, "agent");
            xb_add(&bar[XB_XGEN(b.x)], 1u);
            asm volatile("s_waitcnt vmcnt(0)" ::: "memory");
        } else {
            XB_SPIN(xb_ld(&bar[XB_XGEN(b.x)]) == gen, bar);
            __builtin_amdgcn_fence(__ATOMIC_ACQUIRE, "agent");
            asm volatile("s_waitcnt vmcnt(0)" ::: "memory");
        }
    }
    __syncthreads();
}

struct Params {
    const float *x_p, *x_s, *cache_k, *cache_v, *state_pool; const int* page_table;
    const float *norm_in, *w_in, *w_pool, *pool_scale, *w_out, *rel_bias, *norm_out;
    float* out; unsigned char* ws; int ph_lo, ph_hi;
};

__device__ __forceinline__ unsigned f2bf(float f) { unsigned u = __builtin_bit_cast(unsigned, f); return (u + 0x7fffu + ((u >> 16) & 1u)) >> 16; }
__device__ __forceinline__ unsigned pk2(float lo, float hi) { return f2bf(lo) | (f2bf(hi) << 16); }
__device__ __forceinline__ void p0_transpose_item(const float* W, int K, int N, bf16* WT, LAS float* scr, int item, int lane) {
    const int nblk = N / 32, kb = item / nblk, nb = item % nblk, k0 = 64 * kb, n0 = 32 * nb;
#pragma unroll 8
    for (int i = 0; i < 32; ++i) { const int kk = 2 * i + (lane >> 5); scr[kk * 33 + (lane & 31)] = W[(size_t)(k0 + kk) * N + n0 + (lane & 31)]; }
    LDS_WAIT(); asm volatile("" ::: "memory");
    const int c = lane & 7;
#pragma unroll
    for (int j = 0; j < 4; ++j) { const int n = (lane >> 3) + 8 * j; const LAS float* s = scr + (8 * c) * 33 + n;
        v4u o; o.x = pk2(s[0 * 33], s[1 * 33]); o.y = pk2(s[2 * 33], s[3 * 33]); o.z = pk2(s[4 * 33], s[5 * 33]); o.w = pk2(s[6 * 33], s[7 * 33]);
        *(v4u*)(WT + (size_t)(n0 + n) * K + k0 + 8 * c) = o; }
    LDS_WAIT(); asm volatile("" ::: "memory");
}
__device__ __forceinline__ void rms_row_to_bf16(const float* xrow, const float* gain, bf16* orow, int lane) {
    const f32x4* xr = (const f32x4*)xrow + lane; const f32x4* gr = (const f32x4*)gain + lane;
    f32x4 v[16]; float s = 0.f;
#pragma unroll
    for (int j = 0; j < 16; ++j) { v[j] = xr[64 * j]; s += (v[j].x * v[j].x + v[j].y * v[j].y) + (v[j].z * v[j].z + v[j].w * v[j].w); }
    const float rstd = 1.0f / sqrtf(wave_sum(s) * (1.f / DM) + RMS_EPS);
    v2u* o8 = (v2u*)orow + lane;
#pragma unroll
    for (int j = 0; j < 16; ++j) { const f32x4 g = gr[64 * j]; v2u w; w.x = cvt_pk_bf16(v[j].x * rstd * g.x, v[j].y * rstd * g.y); w.y = cvt_pk_bf16(v[j].z * rstd * g.z, v[j].w * rstd * g.w); o8[64 * j] = w; }
}

typedef const f32x4 (&AccRef)[2][2][4][2];
template <int ACT> __device__ __forceinline__ void epi_store_bf16(AccRef acc, bf16* base, int ldc) {
#pragma unroll
    for (int ai = 0; ai < 2; ++ai)
#pragma unroll
        for (int m = 0; m < 4; ++m) { bf16* rowp = base + (size_t)(ai * 128 + m * 16) * ldc;
#pragma unroll
            for (int bj = 0; bj < 2; ++bj) { f32x4 v0 = acc[ai][bj][m][0], v1 = acc[ai][bj][m][1];
                if (ACT == 1) {
#pragma unroll
                    for (int e = 0; e < 4; ++e) { v0[e] = silu_f(v0[e]); v1[e] = silu_f(v1[e]); } }
                v4u w; w.x = cvt_pk_bf16(v0[0], v0[1]); w.y = cvt_pk_bf16(v0[2], v0[3]); w.z = cvt_pk_bf16(v1[0], v1[1]); w.w = cvt_pk_bf16(v1[2], v1[3]);
                *(v4u*)(rowp + bj * 128) = w; } }
}
struct EpiIn {
    bf16 *Q, *Kb, *Vb, *GA, *Ub, *GP; float* out; float* kms;
    __device__ __forceinline__ void operator()(AccRef acc, const pg8::Unit& u, int wr, int wc, int fr, int fq) const {
        const int pn = u.pn, pm = u.pm, row0 = pm * 256 + wr * 64 + fr, cw = wc * 32 + 8 * fq;
        if (pn < 8) { epi_store_bf16<0>(acc, Q + (size_t)row0 * AW + pn * 256 + cw, AW); }
        else if (pn < 12) {
            const int which = (pn - 8) >> 1, cl = ((pn - 8) & 1) * 256 + cw;
            bf16* ob = (which ? Vb : Kb) + (size_t)row0 * KVW + cl;
            epi_store_bf16<0>(acc, ob, KVW);
            float* of = (pm < 32) ? out + (which ? O_VP : O_KP) + (size_t)row0 * KVW + cl : out + (which ? O_VS : O_KS) + (size_t)(row0 - MP) * KVW + cl;
#pragma unroll
            for (int ai = 0; ai < 2; ++ai)
#pragma unroll
                for (int m = 0; m < 4; ++m) { float* rowp = of + (size_t)(ai * 128 + m * 16) * KVW;
#pragma unroll
                    for (int bj = 0; bj < 2; ++bj) { *(f32x4*)(rowp + bj * 128) = acc[ai][bj][m][0]; *(f32x4*)(rowp + bj * 128 + 4) = acc[ai][bj][m][1]; } }
            if (which == 0 && pm < 32) {
#pragma unroll
                for (int bj = 0; bj < 2; ++bj)
#pragma unroll
                    for (int n = 0; n < 2; ++n) { f32x4 s = (f32x4){0.f, 0.f, 0.f, 0.f};
#pragma unroll
                        for (int ai = 0; ai < 2; ++ai)
#pragma unroll
                            for (int m = 0; m < 4; ++m) s += acc[ai][bj][m][n];
#pragma unroll
                        for (int e = 0; e < 4; ++e) { float x = s[e]; x += __shfl_xor(x, 1); x += __shfl_xor(x, 2); x += __shfl_xor(x, 4); x += __shfl_xor(x, 8); s[e] = x; }
                        if (fr == 0) {
#pragma unroll
                            for (int e = 0; e < 4; ++e) __hip_atomic_fetch_add(kms + pm * KVW + cl + bj * 128 + 4 * n + e, s[e], __ATOMIC_RELAXED, __HIP_MEMORY_SCOPE_AGENT); } }
            }
        }
        else if (pn < 20) { epi_store_bf16<1>(acc, GA + (size_t)row0 * AW + (pn - 12) * 256 + cw, AW); }
        else if (pn < 28) {
            const int cl = (pn - 20) * 256 + cw;
            epi_store_bf16<0>(acc, Ub + (size_t)row0 * PW + cl, PW);
            if (pm >= 31) {
#pragma unroll
                for (int ai = 0; ai < 2; ++ai)
#pragma unroll
                    for (int m = 0; m < 4; ++m) { const int r = row0 + ai * 128 + m * 16; float* rowp = nullptr;
                        if (pm == 31) { if (r >= MP - 15) rowp = out + O_PP + (size_t)(r - (MP - 15)) * PW + cl; }
                        else { const int rs = r - MP; rowp = out + O_PS + (size_t)((rs >> 3) * 15 + 7 + (rs & 7)) * PW + cl; }
                        if (rowp) {
#pragma unroll
                            for (int bj = 0; bj < 2; ++bj) { *(f32x4*)(rowp + bj * 128) = acc[ai][bj][m][0]; *(f32x4*)(rowp + bj * 128 + 4) = acc[ai][bj][m][1]; } } }
            }
        }
        else { epi_store_bf16<1>(acc, GP + (size_t)row0 * PW + (pn - 28) * 256 + cw, PW); }
    }
};
struct EpiPool {
    const bf16* GP; const float* scale; bf16* MIX;
    __device__ __forceinline__ void operator()(AccRef acc, const pg8::Unit& u, int wr, int wc, int fr, int fq) const {
        const int row0 = u.pm * 256 + wr * 64 + fr, col0 = u.pn * 256 + wc * 32 + 8 * fq;
        f32x4 sc[2][2];
#pragma unroll
        for (int bj = 0; bj < 2; ++bj) { sc[bj][0] = *(const f32x4*)(scale + col0 + bj * 128); sc[bj][1] = *(const f32x4*)(scale + col0 + bj * 128 + 4); }
#pragma unroll
        for (int ai = 0; ai < 2; ++ai)
#pragma unroll
            for (int m = 0; m < 4; ++m) { const size_t r = (size_t)(row0 + ai * 128 + m * 16);
#pragma unroll
                for (int bj = 0; bj < 2; ++bj) { const v4u g = *(const v4u*)(GP + r * PW + col0 + bj * 128);
                    const f32x4 v0 = acc[ai][bj][m][0] * sc[bj][0], v1 = acc[ai][bj][m][1] * sc[bj][1];
                    v4u w; w.x = cvt_pk_bf16(v0[0] * bflo(g.x), v0[1] * bfhi(g.x)); w.y = cvt_pk_bf16(v0[2] * bflo(g.y), v0[3] * bfhi(g.y));
                    w.z = cvt_pk_bf16(v1[0] * bflo(g.z), v1[1] * bfhi(g.z)); w.w = cvt_pk_bf16(v1[2] * bflo(g.w), v1[3] * bfhi(g.w));
                    *(v4u*)(MIX + r * DM + AW + col0 + bj * 128) = w; } }
    }
};
struct EpiOut {
    const float *x_p, *x_s; float* Y; float* ssq;
    __device__ __forceinline__ void operator()(AccRef acc, const pg8::Unit& u, int wr, int wc, int fr, int fq) const {
        const int row0 = u.pm * 256 + wr * 64 + fr, col0 = u.pn * 256 + wc * 32 + 8 * fq;
        const float* xb = (u.pm < 32) ? x_p + (size_t)row0 * DM : x_s + (size_t)(row0 - MP) * DM;
#pragma unroll
        for (int ai = 0; ai < 2; ++ai)
#pragma unroll
            for (int m = 0; m < 4; ++m) { const size_t ro = (size_t)(ai * 128 + m * 16) * DM + col0; float ss = 0.f;
#pragma unroll
                for (int bj = 0; bj < 2; ++bj) {
                    const f32x4 h0 = acc[ai][bj][m][0] + *(const f32x4*)(xb + ro + bj * 128), h1 = acc[ai][bj][m][1] + *(const f32x4*)(xb + ro + bj * 128 + 4);
                    *(f32x4*)(Y + (size_t)row0 * DM + ro + bj * 128) = h0; *(f32x4*)(Y + (size_t)row0 * DM + ro + bj * 128 + 4) = h1;
                    ss += (h0[0] * h0[0] + h0[1] * h0[1]) + (h0[2] * h0[2] + h0[3] * h0[3]) + (h1[0] * h1[0] + h1[1] * h1[1]) + (h1[2] * h1[2] + h1[3] * h1[3]); }
                ss += __shfl_xor(ss, 16); ss += __shfl_xor(ss, 32);
                if (fq == 0) ssq[(size_t)(row0 + ai * 128 + m * 16) * 64 + u.pn * 4 + wc] = ss; }
    }
};

#define KSWZ(row, colB) ((row) * 256 + ((colB) ^ (((row) & 7) << 4)))
#define SBAR() __builtin_amdgcn_sched_barrier(0)
__device__ __forceinline__ int crow(int r, int hi) { return (r & 3) + 8 * (r >> 2) + 4 * hi; }
__device__ __forceinline__ int v_st(int k, int c) { const int kk = (k & ~0xC) | ((k & 4) << 1) | ((k & 8) >> 1); return ((kk >> 3) * 4 + (c >> 5)) * 512 + ((kk & 7) * 32 + (c & 31)) * 2; }
__device__ __forceinline__ int v_rd_base(int lane) { return ((lane & 3) << 3) | (((lane >> 2) & 3) << 6) | (((lane >> 4) & 1) << 5) | (((lane >> 5) & 1) << 8); }
constexpr int v_rd_off(int d0, int ks, int half) { return d0 * 512 + ks * 4096 + half * 2048; }
template <int OFF> __device__ __forceinline__ s16x4 tr_read(int vb) { s16x4 r; asm volatile("ds_read_b64_tr_b16 %0, %1 offset:%2" : "=&v"(r) : "v"(vb), "i"(OFF) : "memory"); return r; }
template <int D0> __device__ __forceinline__ void pv_one(f32x16& od, int vb, bf16x8 pa0, bf16x8 pa1, bf16x8 pa2, bf16x8 pa3) {
    const s16x4 l0 = tr_read<v_rd_off(D0, 0, 0)>(vb), h0 = tr_read<v_rd_off(D0, 0, 1)>(vb), l1 = tr_read<v_rd_off(D0, 1, 0)>(vb), h1 = tr_read<v_rd_off(D0, 1, 1)>(vb);
    const s16x4 l2 = tr_read<v_rd_off(D0, 2, 0)>(vb), h2 = tr_read<v_rd_off(D0, 2, 1)>(vb), l3 = tr_read<v_rd_off(D0, 3, 0)>(vb), h3 = tr_read<v_rd_off(D0, 3, 1)>(vb);
    asm volatile("s_waitcnt lgkmcnt(0)" ::: "memory"); SBAR();
#define PKV(L, H) (bf16x8){L[0], L[1], L[2], L[3], H[0], H[1], H[2], H[3]}
    od = __builtin_amdgcn_mfma_f32_32x32x16_bf16(pa0, PKV(l0, h0), od, 0, 0, 0);
    od = __builtin_amdgcn_mfma_f32_32x32x16_bf16(pa1, PKV(l1, h1), od, 0, 0, 0);
    od = __builtin_amdgcn_mfma_f32_32x32x16_bf16(pa2, PKV(l2, h2), od, 0, 0, 0);
    od = __builtin_amdgcn_mfma_f32_32x32x16_bf16(pa3, PKV(l3, h3), od, 0, 0, 0);
#undef PKV
}
__device__ __forceinline__ void qkt(f32x16& p0, f32x16& p1, const LAS char* Ks, const bf16x8 (&qr)[8], int r32, int hi) {
#pragma unroll
    for (int r = 0; r < 16; ++r) { p0[r] = 0.f; p1[r] = 0.f; }
#pragma unroll
    for (int d0 = 0; d0 < 8; ++d0) { const int cb = (d0 * 16 + hi * 8) * 2;
        const bf16x8 b0 = *(const LAS bf16x8*)(Ks + KSWZ(r32, cb));
        const bf16x8 b1 = *(const LAS bf16x8*)(Ks + KSWZ(32 + r32, cb));
        p0 = __builtin_amdgcn_mfma_f32_32x32x16_bf16(b0, qr[d0], p0, 0, 0, 0);
        p1 = __builtin_amdgcn_mfma_f32_32x32x16_bf16(b1, qr[d0], p1, 0, 0, 0); }
}
__device__ __forceinline__ int rel_bucket_i(int n) {
    if (n < 16) return n;
    const int e = 31 - __clz(n); const unsigned long long n2 = (unsigned long long)n * (unsigned long long)n;
    const int b = 2 * e + (int)((n2 >> (2 * e + 1)) != 0ull) + 8; return b > 31 ? 31 : b;
}
struct KVPrompt { const bf16* K; const bf16* V;
    __device__ __forceinline__ void stage(int t, LAS char* Kl, LAS char* Vl, int tid) const {
        const int sr = tid >> 4, sc = (tid & 15) * 8; const size_t o = (size_t)(64 * t + sr) * KVW + sc;
        const bf16x8 k0 = *(const bf16x8*)(K + o), k1 = *(const bf16x8*)(K + o + 32 * KVW), v0 = *(const bf16x8*)(V + o), v1 = *(const bf16x8*)(V + o + 32 * KVW);
        *(LAS bf16x8*)(Kl + KSWZ(sr, sc * 2)) = k0; *(LAS bf16x8*)(Kl + KSWZ(32 + sr, sc * 2)) = k1;
        *(LAS bf16x8*)(Vl + v_st(sr, sc)) = v0; *(LAS bf16x8*)(Vl + v_st(32 + sr, sc)) = v1; } };
struct KVPaged { const float* ck; const float* cv; const int* pt;
    __device__ __forceinline__ void stage(int t, LAS char* Kl, LAS char* Vl, int tid) const {
        const int sr = tid >> 4, sc = (tid & 15) * 8; const int page = pt[t >> 1];
        const size_t o = ((size_t)page * 128 + 64 * (t & 1) + sr) * KVW + sc;
        f32x4 a[8];
        a[0] = *(const f32x4*)(ck + o); a[1] = *(const f32x4*)(ck + o + 4); a[2] = *(const f32x4*)(ck + o + 32 * KVW); a[3] = *(const f32x4*)(ck + o + 32 * KVW + 4);
        a[4] = *(const f32x4*)(cv + o); a[5] = *(const f32x4*)(cv + o + 4); a[6] = *(const f32x4*)(cv + o + 32 * KVW); a[7] = *(const f32x4*)(cv + o + 32 * KVW + 4);
        v4u w[4];
#pragma unroll
        for (int i = 0; i < 4; ++i) { w[i].x = cvt_pk_bf16(a[2 * i][0], a[2 * i][1]); w[i].y = cvt_pk_bf16(a[2 * i][2], a[2 * i][3]); w[i].z = cvt_pk_bf16(a[2 * i + 1][0], a[2 * i + 1][1]); w[i].w = cvt_pk_bf16(a[2 * i + 1][2], a[2 * i + 1][3]); }
        *(LAS v4u*)(Kl + KSWZ(sr, sc * 2)) = w[0]; *(LAS v4u*)(Kl + KSWZ(32 + sr, sc * 2)) = w[1];
        *(LAS v4u*)(Vl + v_st(sr, sc)) = w[2]; *(LAS v4u*)(Vl + v_st(32 + sr, sc)) = w[3]; } };

template <bool CAUSAL, class KVSrc>
__device__ __forceinline__ void attn_block(LAS char* lds, const bf16x8 (&qr)[8], int dq0, int hl, bool active, const KVSrc& src, float& m_reg, float& l_reg, f32x16 (&o)[4], int tid, int wid, int lane) {
    const int r32 = lane & 31, hi = lane >> 5;
    LAS char* Kl = lds + ATT_KV; LAS char* Vl = lds + ATT_KV + 16384;
    LAS float* al_l = (LAS float*)(lds + ATT_WS + wid * 256);
    const LAS float* tab = (const LAS float*)(lds + ATT_TAB) + hl * TABN;
    const int vb = (int)(unsigned)(size_t)Vl + v_rd_base(lane);
    m_reg = -1e30f; l_reg = 0.f;
#pragma unroll
    for (int d = 0; d < 4; ++d)
#pragma unroll
        for (int r = 0; r < 16; ++r) o[d][r] = 0.f;
    for (int t = 0; t < 4; ++t) {
        __syncthreads();
        src.stage(t, Kl, Vl, tid);
        __syncthreads();
        if (active && (!CAUSAL || 64 * t <= 32 * wid + 31)) {
            f32x16 p0, p1;
            qkt(p0, p1, Kl, qr, r32, hi);
            const int dq = dq0 - 64 * t; const int dqc = dq < 2960 ? dq : 2960;
            const LAS float* tb = tab + (dqc + TAB_NEG - 63 - 4 * hi);
#pragma unroll
            for (int r = 0; r < 16; ++r) { const int k0 = (r & 3) + 8 * (r >> 2);
                p0[r] = fmaf(p0[r], C_SC, tb[63 - k0]); p1[r] = fmaf(p1[r], C_SC, tb[31 - k0]);
                if (CAUSAL) { if (k0 + 4 * hi > dq) p0[r] = -1e30f; if (32 + k0 + 4 * hi > dq) p1[r] = -1e30f; } }
            float pmax = p0[0];
#pragma unroll
            for (int r = 1; r < 16; ++r) pmax = fmaxf(pmax, p0[r]);
#pragma unroll
            for (int r = 0; r < 16; ++r) pmax = fmaxf(pmax, p1[r]);
            { auto rr = __builtin_amdgcn_permlane32_swap(__float_as_uint(pmax), __float_as_uint(pmax), false, false); pmax = fmaxf(__uint_as_float(rr[0]), __uint_as_float(rr[1])); }
            const float mn = fmaxf(m_reg, pmax), alpha = __builtin_amdgcn_exp2f(m_reg - mn); m_reg = mn;
            float ps = 0.f;
#pragma unroll
            for (int r = 0; r < 16; ++r) { p0[r] = __builtin_amdgcn_exp2f(p0[r] - mn); p1[r] = __builtin_amdgcn_exp2f(p1[r] - mn); ps += p0[r] + p1[r]; }
            { auto rr = __builtin_amdgcn_permlane32_swap(__float_as_uint(ps), __float_as_uint(ps), false, false); ps = __uint_as_float(rr[0]) + __uint_as_float(rr[1]); }
            l_reg = l_reg * alpha + ps;
            bf16x8 pa0, pa1, pa2, pa3;
#define PK4(P, BASE, OUT) do { unsigned a0 = cvt_pk_bf16(P[BASE + 0], P[BASE + 1]), a1 = cvt_pk_bf16(P[BASE + 2], P[BASE + 3]); \
        unsigned b0 = cvt_pk_bf16(P[BASE + 4], P[BASE + 5]), b1 = cvt_pk_bf16(P[BASE + 6], P[BASE + 7]); \
        auto r0 = __builtin_amdgcn_permlane32_swap(a0, b0, false, false); auto r1 = __builtin_amdgcn_permlane32_swap(a1, b1, false, false); \
        v4u w = {r0[0], r1[0], r0[1], r1[1]}; OUT = *reinterpret_cast<bf16x8*>(&w); } while (0)
            PK4(p0, 0, pa0); PK4(p0, 8, pa1); PK4(p1, 0, pa2); PK4(p1, 8, pa3);
#undef PK4
            if (__any(alpha < 1.f)) {
                if (hi == 0) al_l[r32] = alpha;
                LDS_WAIT();
#pragma unroll
                for (int r = 0; r < 16; ++r) { const float a = al_l[crow(r, hi)];
#pragma unroll
                    for (int d = 0; d < 4; ++d) o[d][r] *= a; }
            }
            pv_one<0>(o[0], vb, pa0, pa1, pa2, pa3); pv_one<1>(o[1], vb, pa0, pa1, pa2, pa3); pv_one<2>(o[2], vb, pa0, pa1, pa2, pa3); pv_one<3>(o[3], vb, pa0, pa1, pa2, pa3);
        }
    }
}
__device__ __forceinline__ void stage_o_rows(LAS char* lds, const f32x16 (&o)[4], float l_reg, int wid, int lane) {
    const int r32 = lane & 31, hi = lane >> 5;
    LAS float* al_l = (LAS float*)(lds + ATT_WS + wid * 256);
    LAS bf16* Os = (LAS bf16*)(lds + ATT_KV + wid * 8192);
    if (hi == 0) al_l[r32] = 1.0f / l_reg;
    LDS_WAIT();
#pragma unroll
    for (int r = 0; r < 16; ++r) { const int row = crow(r, hi); const float inv = al_l[row];
#pragma unroll
        for (int d = 0; d < 4; ++d) Os[row * 128 + 32 * d + r32] = (bf16)f2bf(o[d][r] * inv); }
    LDS_WAIT();
}
__device__ __forceinline__ void build_bias_table(LAS char* lds, const float* rel_bias, int kvh, int tid) {
    LAS float* tab = (LAS float*)(lds + ATT_TAB);
    for (int e = tid; e < 4 * TABN; e += 512) { const int hl = e / TABN, i = e - hl * TABN; int d = i - TAB_NEG; d = d < 0 ? 0 : d;
        tab[e] = rel_bias[rel_bucket_i(d) * NH + kvh * 4 + hl] * LOG2E; }
}

__global__ void __launch_bounds__(512, 2) moba_fwd(Params P) {
    extern __shared__ __attribute__((aligned(16))) unsigned char lds_raw[];
    LAS unsigned char* lds = (LAS unsigned char*)lds_raw;
    LAS char* ldc = (LAS char*)lds_raw;
    const int tid = threadIdx.x, lane = tid & 63, wid = __builtin_amdgcn_readfirstlane(tid >> 6);
    const int G = gridDim.x, bid = blockIdx.x;
    unsigned char* ws = P.ws;
    unsigned* ctl = (unsigned*)(ws + WS_CTL);
    bf16* WinT = (bf16*)(ws + WS_WIN); bf16* WoutT = (bf16*)(ws + WS_WOUT); bf16* WpT = (bf16*)(ws + WS_WP); bf16* XN = (bf16*)(ws + WS_XN);
    bf16* Qb = (bf16*)(ws + WS_Q); bf16* GA = (bf16*)(ws + WS_GA); bf16* Ub = (bf16*)(ws + WS_U); bf16* GP = (bf16*)(ws + WS_GP); bf16* ZP = (bf16*)(ws + WS_ZP);
    bf16* Kb = (bf16*)(ws + WS_K); bf16* Vb = (bf16*)(ws + WS_V); bf16* MIX = (bf16*)(ws + WS_MIX);
    float* CMEAN = (float*)(ws + WS_CMEAN); unsigned* LP = (unsigned*)(ws + WS_LP); unsigned* LS = (unsigned*)(ws + WS_LS);
    bf16* PO = (bf16*)(ws + WS_PO); float* PL = (float*)(ws + WS_PL); float* SSQ = (float*)(ws + WS_SSQ);
    float* KMS = (float*)(ctl + CW_KMS); unsigned* cntP = ctl + CW_CNTP; unsigned* cntS = ctl + CW_CNTS;

    for (int u = tid; u < (LDS_BYTES - LDSCTL_OFF) / 4; u += 512) ((LAS unsigned*)(lds + LDSCTL_OFF))[u] = 0u;
    __syncthreads();
    volatile LAS unsigned* MISC = (volatile LAS unsigned*)(lds + LDSCTL_OFF + 320);
    XcdBarrier bar; bar.bar = ctl + CW_BAR; bar.x = 0; bar.st = nullptr;
    if (MK_N_LAUNCHES == 1) bar = xcd_barrier_post(ctl + CW_BAR, MISC + 8);
    const int lo = P.ph_lo, hi_ph = P.ph_hi;
#define IN(k) (lo <= (k) && (k) < hi_ph)
#define SEAM(k) do { if (MK_N_LAUNCHES == 1 && IN(k) && IN((k) + 1)) xcd_barrier(bar); } while (0)

    if (IN(0)) {
        LAS float* scr = (LAS float*)(lds + wid * 16384);
        const int gw = bid * 8 + wid, NGW = G * 8;
        constexpr int I_IN = (DM / 64) * (NIN / 32), I_OUT = (DM / 64) * (DM / 32), I_PG = (512 / 64) * (512 / 32);
        for (int it = gw; it < I_IN + I_OUT + 4 * I_PG; it += NGW) {
            int r = it;
            if (r < I_IN) { p0_transpose_item(P.w_in, DM, NIN, WinT, scr, r, lane); continue; } r -= I_IN;
            if (r < I_OUT) { p0_transpose_item(P.w_out, DM, DM, WoutT, scr, r, lane); continue; } r -= I_OUT;
            const int g = r / I_PG; p0_transpose_item(P.w_pool + (size_t)g * 512 * 512, 512, 512, WpT + (size_t)g * 512 * 512, scr, r - g * I_PG, lane);
        }
        for (int m = gw; m < MT; m += NGW) rms_row_to_bf16(m < MP ? P.x_p + (size_t)m * DM : P.x_s + (size_t)(m - MP) * DM, P.norm_in, XN + (size_t)m * DM, lane);
        __syncthreads();
        {
            LAS f32x4* red = (LAS f32x4*)lds;
            const int c4 = tid & 127, rg = tid >> 7;
            for (int it = bid; it < 32 * 32; it += G) {
                const int b = it >> 5, j = it & 31;
                f32x4 acc = (f32x4){0.f, 0.f, 0.f, 0.f};
#pragma unroll
                for (int hpg = 0; hpg < 2; ++hpg) {
                    const int page = P.page_table[b * 64 + 2 * j + hpg];
                    const float* base = P.cache_k + ((size_t)page * 128 + rg) * KVW + c4 * 4;
#pragma unroll 8
                    for (int rr = 0; rr < 32; ++rr) acc += *(const f32x4*)(base + (size_t)(4 * rr) * KVW);
                }
                red[rg * 128 + c4] = acc;
                __syncthreads();
                if (rg == 0) { const f32x4 s = (red[c4] + red[128 + c4]) + (red[256 + c4] + red[384 + c4]); *(f32x4*)(CMEAN + (size_t)it * KVW + c4 * 4) = s * (1.0f / 256.0f); }
                __syncthreads();
            }
        }
    }
    SEAM(0);

    if (IN(1)) {
        pg8::Gemm g{XN, WinT, MT, NIN, DM, DM, DM, 0, 0}; pg8::StaticOrder S; S.init(MT, NIN, G, bid);
        EpiIn E{Qb, Kb, Vb, GA, Ub, GP, P.out, KMS};
        pg8::gemm_phase<EpiIn>(lds, g, S, E);
    }
    SEAM(1);

    if (IN(2)) {
        LAS float* KM = (LAS float*)lds;
        LAS int* cntL = (LAS int*)(lds + 65536); LAS int* baseL = cntL + 128; LAS int* SELL = baseL + 128; LAS int* LPL = SELL + 32 * 48;
        const int h = lane >> 2, part = lane & 3, kvh = h >> 2;
        for (int ch = bid; ch < 256 + 32; ch += G) {
            const bool smp = ch >= 256; const int b_s = ch - 256;
            const int nblk = smp ? 32 : (ch >> 3);
            const int nvalid = nblk < 3 ? nblk : 3;
            __syncthreads();
            if (smp) { for (int e = tid; e < 32 * 128; e += 512) ((LAS f32x4*)KM)[e] = *(const f32x4*)(CMEAN + (size_t)b_s * 32 * KVW + e * 4); }
            else { for (int e = tid; e < nblk * 128; e += 512) ((LAS f32x4*)KM)[e] = *(const f32x4*)(KMS + e * 4) * (1.0f / 256.0f); }
            if (tid < 128) cntL[tid] = 0;
            __syncthreads();
            const int nrow = smp ? 1 : 4;
            for (int i = 0; i < nrow; ++i) {
                const int rl = smp ? wid : wid * 4 + i;
                const int r = smp ? MP + b_s * 8 + wid : ch * 32 + rl;
                float q[32];
                { const v4u* qp = (const v4u*)(Qb + (size_t)r * AW + h * 128 + part * 32);
#pragma unroll
                  for (int c = 0; c < 4; ++c) { const v4u w = qp[c]; q[8 * c + 0] = bflo(w.x); q[8 * c + 1] = bfhi(w.x); q[8 * c + 2] = bflo(w.y); q[8 * c + 3] = bfhi(w.y);
                      q[8 * c + 4] = bflo(w.z); q[8 * c + 5] = bfhi(w.z); q[8 * c + 6] = bflo(w.w); q[8 * c + 7] = bfhi(w.w); } }
                float v0 = -3.0e38f, v1 = -3.0e38f, v2 = -3.0e38f; int i0 = 0, i1 = 0, i2 = 0;
                for (int n = 0; n < nblk; ++n) {
                    const LAS f32x4* km = (const LAS f32x4*)(KM + n * KVW + kvh * 128 + part * 32);
                    float a = 0.f;
#pragma unroll
                    for (int c = 0; c < 8; ++c) { const f32x4 k4 = km[c]; a = fmaf(q[4 * c], k4.x, a); a = fmaf(q[4 * c + 1], k4.y, a); a = fmaf(q[4 * c + 2], k4.z, a); a = fmaf(q[4 * c + 3], k4.w, a); }
                    a += __shfl_xor(a, 1); a += __shfl_xor(a, 2);
                    if (a > v0) { v2 = v1; i2 = i1; v1 = v0; i1 = i0; v0 = a; i0 = n; }
                    else if (a > v1) { v2 = v1; i2 = i1; v1 = a; i1 = n; }
                    else if (a > v2) { v2 = a; i2 = n; }
                }
                if (part == 0) {
                    const int e0 = (rl * 16 + h) * 3;
                    if (nvalid > 0) { SELL[e0] = i0; LPL[e0] = __hip_atomic_fetch_add(&cntL[kvh * 32 + i0], 1, __ATOMIC_RELAXED, __HIP_MEMORY_SCOPE_WORKGROUP); }
                    if (nvalid > 1) { SELL[e0 + 1] = i1; LPL[e0 + 1] = __hip_atomic_fetch_add(&cntL[kvh * 32 + i1], 1, __ATOMIC_RELAXED, __HIP_MEMORY_SCOPE_WORKGROUP); }
                    if (nvalid > 2) { SELL[e0 + 2] = i2; LPL[e0 + 2] = __hip_atomic_fetch_add(&cntL[kvh * 32 + i2], 1, __ATOMIC_RELAXED, __HIP_MEMORY_SCOPE_WORKGROUP); }
                }
            }
            __syncthreads();
            if (tid < 128) { const int c = cntL[tid];
                if (smp) { baseL[tid] = 0; cntS[b_s * 128 + tid] = (unsigned)c; }
                else baseL[tid] = c ? (int)__hip_atomic_fetch_add(cntP + tid, (unsigned)c, __ATOMIC_RELAXED, __HIP_MEMORY_SCOPE_AGENT) : 0; }
            __syncthreads();
            const int nent = (smp ? 8 : 32) * 48;
            for (int e = tid; e < nent; e += 512) { const int s = e % 3; if (s >= nvalid) continue;
                const int hh = (e / 3) & 15, rl = e / 48, j = SELL[e], lp = LPL[e], li = (hh >> 2) * 32 + j;
                if (smp) LS[((size_t)b_s * 128 + li) * 32 + lp] = (unsigned)(rl | ((hh & 3) << 3) | (s << 5));
                else LP[(size_t)li * LP_CAP + baseL[li] + lp] = (unsigned)((ch * 32 + rl) | ((hh & 3) << 13) | (s << 15)); }
        }
        for (int task = bid * 512 + tid; task < MT * 256; task += G * 512) {
            const int r = task >> 8, col = (task & 255) * 8, w = 2 << (col >> 9);
            float s[8], u0[8];
#pragma unroll
            for (int e = 0; e < 8; ++e) s[e] = 0.f;
            int cnt = w;
            if (r < MP) { cnt = (r + 1) < w ? (r + 1) : w;
                for (int i = 0; i < cnt; ++i) { const v4u x = *(const v4u*)(Ub + (size_t)(r - i) * PW + col);
                    const float f[8] = {bflo(x.x), bfhi(x.x), bflo(x.y), bfhi(x.y), bflo(x.z), bfhi(x.z), bflo(x.w), bfhi(x.w)};
#pragma unroll
                    for (int e = 0; e < 8; ++e) { s[e] += f[e]; if (i == 0) u0[e] = f[e]; } } }
            else { const int rs = r - MP, b = rs >> 3, t = rs & 7;
                for (int i = 0; i < w; ++i) { const int tt = t - i;
                    if (tt >= 0) { const v4u x = *(const v4u*)(Ub + (size_t)(MP + b * 8 + tt) * PW + col);
                        const float f[8] = {bflo(x.x), bfhi(x.x), bflo(x.y), bfhi(x.y), bflo(x.z), bfhi(x.z), bflo(x.w), bfhi(x.w)};
#pragma unroll
                        for (int e = 0; e < 8; ++e) { s[e] += f[e]; if (i == 0) u0[e] = f[e]; } }
                    else { const float* sp = P.state_pool + (size_t)(b * 15 + 15 + tt) * PW + col; const f32x4 a = *(const f32x4*)sp, c = *(const f32x4*)(sp + 4);
                        s[0] += a.x; s[1] += a.y; s[2] += a.z; s[3] += a.w; s[4] += c.x; s[5] += c.y; s[6] += c.z; s[7] += c.w; } } }
            const float inv = 1.0f / (float)cnt;
            v4u o; o.x = cvt_pk_bf16(s[0] * inv - u0[0], s[1] * inv - u0[1]); o.y = cvt_pk_bf16(s[2] * inv - u0[2], s[3] * inv - u0[3]);
            o.z = cvt_pk_bf16(s[4] * inv - u0[4], s[5] * inv - u0[5]); o.w = cvt_pk_bf16(s[6] * inv - u0[6], s[7] * inv - u0[7]);
            *(v4u*)(ZP + (size_t)r * PW + col) = o;
        }
        for (int e = bid * 512 + tid; e < 32 * 7 * (PW / 4); e += G * 512) { const int c4 = e % (PW / 4), rr = (e / (PW / 4)) % 7, b = e / (7 * (PW / 4));
            *(f32x4*)(P.out + O_PS + (size_t)(b * 15 + rr) * PW + c4 * 4) = *(const f32x4*)(P.state_pool + (size_t)(b * 15 + 8 + rr) * PW + c4 * 4); }
    }
    SEAM(2);

    if (IN(3)) {
        {
            pg8::Gemm g{ZP, WpT, MT, PW, 512, PW, 512, 1, 512}; pg8::StaticOrder S; S.init(MT, PW, G, bid);
            EpiPool E{GP, P.pool_scale, MIX};
            pg8::gemm_phase<EpiPool>(lds, g, S, E);
        }
        const int kvh = bid & 3, gsub = bid >> 2, ngsub = G >> 2;
        __syncthreads();
        build_bias_table(ldc, P.rel_bias, kvh, tid);
        LAS int* pref = (LAS int*)(lds + ATT_PREF);
        if (tid == 0) { int a = 0; for (int j = 0; j < 32; ++j) { pref[j] = a; a += (int)((cntP[kvh * 32 + j] + 255u) >> 8); } pref[32] = a; }
        __syncthreads();
        const int npi = pref[32], r32 = lane & 31, hi = lane >> 5;
        for (int it = gsub; it < npi + 1024; it += ngsub) {
            bf16x8 qr[8]; float m_reg, l_reg; f32x16 o[4];
            unsigned ent = 0; bool valid = false; int dq0 = 0, cnt_rows; size_t pidx = 0;
            if (it < npi) {
                int j = 0; while (pref[j + 1] <= it) ++j;
                const int tile = it - pref[j]; const int cnt = (int)cntP[kvh * 32 + j];
                cnt_rows = cnt - tile * 256; const int idx = tile * 256 + wid * 32 + r32;
                valid = idx < cnt; ent = valid ? LP[(size_t)(kvh * 32 + j) * LP_CAP + idx] : 0u;
                const int q = ent & 8191, hl = (ent >> 13) & 3, s = (ent >> 15) & 3;
                const bf16* qp = Qb + (size_t)q * AW + (kvh * 4 + hl) * 128 + hi * 8;
#pragma unroll
                for (int d0 = 0; d0 < 8; ++d0) qr[d0] = *(const bf16x8*)(qp + d0 * 16);
                dq0 = q - 256 * j; pidx = ((size_t)q * NH + kvh * 4 + hl) * 3 + s;
                KVPrompt src{Kb + (size_t)(256 * j) * KVW + kvh * 128, Vb + (size_t)(256 * j) * KVW + kvh * 128};
                attn_block<false, KVPrompt>(ldc, qr, dq0, hl, wid * 32 < cnt_rows, src, m_reg, l_reg, o, tid, wid, lane);
            } else {
                const int si = it - npi, b = si >> 5, j = si & 31; const int cnt = (int)cntS[b * 128 + kvh * 32 + j];
                if (cnt == 0) continue;
                cnt_rows = cnt; const int idx = wid * 32 + r32;
                valid = idx < cnt; ent = valid ? LS[((size_t)b * 128 + kvh * 32 + j) * 32 + idx] : 0u;
                const int t = ent & 7, hl = (ent >> 3) & 3, s = (ent >> 5) & 3; const int row = MP + b * 8 + t;
                const bf16* qp = Qb + (size_t)row * AW + (kvh * 4 + hl) * 128 + hi * 8;
#pragma unroll
                for (int d0 = 0; d0 < 8; ++d0) qr[d0] = *(const bf16x8*)(qp + d0 * 16);
                dq0 = MP + t - 256 * j; pidx = ((size_t)row * NH + kvh * 4 + hl) * 3 + s;
                KVPaged src{P.cache_k + kvh * 128, P.cache_v + kvh * 128, P.page_table + b * 64 + 2 * j};
                attn_block<false, KVPaged>(ldc, qr, dq0, hl, wid * 32 < cnt_rows, src, m_reg, l_reg, o, tid, wid, lane);
            }
            __syncthreads();
            if (wid * 32 < cnt_rows) {
                stage_o_rows(ldc, o, l_reg, wid, lane);
                if (valid && hi == 0) PL[pidx] = m_reg + __builtin_amdgcn_logf(l_reg);
                const int rr = lane >> 1, half = lane & 1;
                const int pv = __shfl((int)valid, rr); const unsigned plo = __shfl((unsigned)(pidx & 0xffffffffu), rr);
                if (pv) { const LAS v4u* srow = (const LAS v4u*)(ldc + ATT_KV + wid * 8192 + rr * 256 + half * 128); v4u* dst = (v4u*)(PO + (size_t)plo * 128 + half * 64);
#pragma unroll
                    for (int c = 0; c < 8; ++c) dst[c] = srow[c]; }
            }
        }
    }
    SEAM(3);

    if (IN(4)) {
        const int kvh = bid & 3, gsub = bid >> 2, ngsub = G >> 2;
        __syncthreads();
        build_bias_table(ldc, P.rel_bias, kvh, tid);
        __syncthreads();
        const int r32 = lane & 31, hi = lane >> 5;
        for (int it = gsub; it < 128; it += ngsub) {
            const int b = it >> 2, hl = it & 3, h = kvh * 4 + hl;
            const int q = 256 * b + wid * 32 + r32;
            bf16x8 qr[8]; float m_reg, l_reg; f32x16 o[4];
            const bf16* qp = Qb + (size_t)q * AW + h * 128 + hi * 8;
#pragma unroll
            for (int d0 = 0; d0 < 8; ++d0) qr[d0] = *(const bf16x8*)(qp + d0 * 16);
            KVPrompt src{Kb + (size_t)(256 * b) * KVW + kvh * 128, Vb + (size_t)(256 * b) * KVW + kvh * 128};
            attn_block<true, KVPrompt>(ldc, qr, wid * 32 + r32, hl, true, src, m_reg, l_reg, o, tid, wid, lane);
            __syncthreads();
            stage_o_rows(ldc, o, l_reg, wid, lane);
            const float lse_own_l = m_reg + __builtin_amdgcn_logf(l_reg);
            const int rr = lane >> 1, half = lane & 1, qq = 256 * b + wid * 32 + rr;
            const float lse_own = __shfl(lse_own_l, rr);
            const int nv = b < 3 ? b : 3; const size_t pbase = ((size_t)qq * NH + h) * 3;
            float ls[3], wsl[3]; float M = lse_own;
#pragma unroll
            for (int s = 0; s < 3; ++s) { ls[s] = (s < nv) ? PL[pbase + s] : -1e30f; M = fmaxf(M, ls[s]); }
            const float w_own = __builtin_amdgcn_exp2f(lse_own - M); float W = w_own;
#pragma unroll
            for (int s = 0; s < 3; ++s) { wsl[s] = (s < nv) ? __builtin_amdgcn_exp2f(ls[s] - M) : 0.f; W += wsl[s]; }
            const float invW = 1.0f / W;
            const LAS v4u* srow = (const LAS v4u*)(ldc + ATT_KV + wid * 8192 + rr * 256 + half * 128);
            const v4u* ga = (const v4u*)(GA + (size_t)qq * AW + h * 128 + half * 64); v4u* dst = (v4u*)(MIX + (size_t)qq * DM + h * 128 + half * 64);
#pragma unroll
            for (int c = 0; c < 8; ++c) { const v4u a = srow[c]; float f[8] = {bflo(a.x) * w_own, bfhi(a.x) * w_own, bflo(a.y) * w_own, bfhi(a.y) * w_own, bflo(a.z) * w_own, bfhi(a.z) * w_own, bflo(a.w) * w_own, bfhi(a.w) * w_own};
#pragma unroll
                for (int s = 0; s < 3; ++s) if (s < nv) { const v4u p = *((const v4u*)(PO + (pbase + s) * 128 + half * 64) + c); const float ww = wsl[s];
                    f[0] += ww * bflo(p.x); f[1] += ww * bfhi(p.x); f[2] += ww * bflo(p.y); f[3] += ww * bfhi(p.y); f[4] += ww * bflo(p.z); f[5] += ww * bfhi(p.z); f[6] += ww * bflo(p.w); f[7] += ww * bfhi(p.w); }
                const v4u g = ga[c]; v4u w;
                w.x = cvt_pk_bf16(f[0] * invW * bflo(g.x), f[1] * invW * bfhi(g.x)); w.y = cvt_pk_bf16(f[2] * invW * bflo(g.y), f[3] * invW * bfhi(g.y));
                w.z = cvt_pk_bf16(f[4] * invW * bflo(g.z), f[5] * invW * bfhi(g.z)); w.w = cvt_pk_bf16(f[6] * invW * bflo(g.w), f[7] * invW * bfhi(g.w));
                dst[c] = w; }
        }
        for (int task = bid * 8 + wid; task < MS * NH; task += G * 8) {
            const int h = task & 15, rs = task >> 4, b = rs >> 3, t = rs & 7, row = MP + rs, kv = h >> 2;
            const unsigned qw = *(const unsigned*)(Qb + (size_t)row * AW + h * 128 + 2 * lane); const float q0 = bflo(qw), q1 = bfhi(qw);
            float x[8], vx[8], vy[8]; const size_t pbase = ((size_t)row * NH + h) * 3;
            float M = fmaxf(fmaxf(PL[pbase], PL[pbase + 1]), PL[pbase + 2]);
#pragma unroll
            for (int tp = 0; tp < 8; ++tp) { x[tp] = -1e30f; vx[tp] = 0.f; vy[tp] = 0.f;
                if (tp <= t) { const size_t ko = (size_t)(MP + b * 8 + tp) * KVW + kv * 128 + 2 * lane; const unsigned kw = *(const unsigned*)(Kb + ko), vw = *(const unsigned*)(Vb + ko);
                    x[tp] = wave_sum(q0 * bflo(kw) + q1 * bfhi(kw)) * C_SC + P.rel_bias[(t - tp) * NH + h] * LOG2E; vx[tp] = bflo(vw); vy[tp] = bfhi(vw); M = fmaxf(M, x[tp]); } }
            float W = 0.f, a0 = 0.f, a1 = 0.f;
#pragma unroll
            for (int tp = 0; tp < 8; ++tp) { const float w = (tp <= t) ? __builtin_amdgcn_exp2f(x[tp] - M) : 0.f; W += w; a0 += w * vx[tp]; a1 += w * vy[tp]; }
#pragma unroll
            for (int s = 0; s < 3; ++s) { const float w = __builtin_amdgcn_exp2f(PL[pbase + s] - M); const unsigned pw = *(const unsigned*)(PO + (pbase + s) * 128 + 2 * lane); W += w; a0 += w * bflo(pw); a1 += w * bfhi(pw); }
            const unsigned gw = *(const unsigned*)(GA + (size_t)row * AW + h * 128 + 2 * lane); const float inv = 1.0f / W;
            *(unsigned*)(MIX + (size_t)row * DM + h * 128 + 2 * lane) = cvt_pk_bf16(a0 * inv * bflo(gw), a1 * inv * bfhi(gw));
        }
    }
    SEAM(4);

    if (IN(5)) {
        pg8::Gemm g{MIX, WoutT, MT, DM, DM, DM, DM, 0, 0}; pg8::StaticOrder S; S.init(MT, DM, G, bid);
        EpiOut E{P.x_p, P.x_s, P.out + O_Y, SSQ};
        pg8::gemm_phase<EpiOut>(lds, g, S, E);
    }
    SEAM(5);

    if (IN(6)) {
        for (int m = bid * 8 + wid; m < MT; m += G * 8) {
            const float ss = wave_sum(SSQ[(size_t)m * 64 + lane]);
            const float rstd = 1.0f / sqrtf(ss * (1.f / DM) + RMS_EPS);
            f32x4* y = (f32x4*)(P.out + O_Y + (size_t)m * DM) + lane; const f32x4* gn = (const f32x4*)P.norm_out + lane;
#pragma unroll
            for (int j = 0; j < 16; ++j) { const f32x4 g = gn[64 * j]; f32x4 v = y[64 * j]; v.x *= rstd * g.x; v.y *= rstd * g.y; v.z *= rstd * g.z; v.w *= rstd * g.w; y[64 * j] = v; }
        }
    }
#undef IN
#undef SEAM
}

extern "C" void kernel_launch(void* const* d_in, const int* in_sizes, int n_in, void* d_out, int out_size, void* d_ws, size_t ws_size, hipStream_t stream) {
    static int grid = 0;
    if (grid == 0) {
        if (n_in != 13 || (size_t)out_size != O_END || ws_size < WS_END) { fprintf(stderr, "kernel_launch: unexpected shapes (n_in %d out %d ws %zu)\n", n_in, out_size, ws_size); grid = -1; return; }
        int dev = 0, cus = 0, per_cu = 0;
        if (hipGetDevice(&dev) != hipSuccess || hipDeviceGetAttribute(&cus, hipDeviceAttributeMultiprocessorCount, dev) != hipSuccess) { grid = -1; return; }
        if (hipFuncSetAttribute((const void*)moba_fwd, hipFuncAttributeMaxDynamicSharedMemorySize, LDS_BYTES) != hipSuccess) { fprintf(stderr, "kernel_launch: hipFuncSetAttribute failed\n"); grid = -1; return; }
        if (hipOccupancyMaxActiveBlocksPerMultiprocessor(&per_cu, (const void*)moba_fwd, 512, LDS_BYTES) != hipSuccess || per_cu < 1) fprintf(stderr, "kernel_launch: occupancy query reports %d\n", per_cu);
        (void)hipGetLastError();
        grid = cus;
        if (grid % 4 != 0) { fprintf(stderr, "kernel_launch: grid %d not a multiple of 4\n", grid); grid = -1; return; }
    }
    if (grid < 0) return;
    (void)hipMemsetAsync((char*)d_ws + WS_CTL, 0, CTL_ZERO_BYTES, stream);
    Params p{};
    p.x_p = (const float*)d_in[0]; p.x_s = (const float*)d_in[1]; p.cache_k = (const float*)d_in[2]; p.cache_v = (const float*)d_in[3]; p.state_pool = (const float*)d_in[4];
    p.page_table = (const int*)d_in[5]; p.norm_in = (const float*)d_in[6]; p.w_in = (const float*)d_in[7]; p.w_pool = (const float*)d_in[8]; p.pool_scale = (const float*)d_in[9];
    p.w_out = (const float*)d_in[10]; p.rel_bias = (const float*)d_in[11]; p.norm_out = (const float*)d_in[12];
    p.out = (float*)d_out; p.ws = (unsigned char*)d_ws;
#if MK_N_LAUNCHES == 1
    p.ph_lo = 0; p.ph_hi = 7;
    hipLaunchKernelGGL(moba_fwd, dim3(grid), dim3(512), LDS_BYTES, stream, p);
#else
    for (int ph = 0; ph < 7; ++ph) { p.ph_lo = ph; p.ph_hi = ph + 1; hipLaunchKernelGGL(moba_fwd, dim3(grid), dim3(512), LDS_BYTES, stream, p); }
#endif
}
```

```cpp
#include <hip/hip_runtime.h>
#include <cstdio>
#include <cstdint>

#ifndef MK_N_LAUNCHES
#define MK_N_LAUNCHES 1
#endif

#ifndef PROBE_REP
#define PROBE_REP -1
#endif
#define GAS __attribute__((address_space(1)))
#define LAS __attribute__((address_space(3)))
typedef unsigned short bf16;
typedef unsigned v4u __attribute__((ext_vector_type(4)));
typedef unsigned v2u __attribute__((ext_vector_type(2)));
typedef float f32x4 __attribute__((ext_vector_type(4)));
typedef float f32x2 __attribute__((ext_vector_type(2)));
typedef float f32x16 __attribute__((ext_vector_type(16)));
typedef short bf16x8 __attribute__((ext_vector_type(8)));
typedef short s16x4 __attribute__((ext_vector_type(4)));

constexpr int MP = 8192, MS = 256, MT = MP + MS, DM = 4096, NIN = 9216, AW = 2048, KVW = 512, PW = 2048, NH = 16;
constexpr float LOG2E = 1.4426950408889634f;
constexpr float C_SC = 0.08838834764831845f * LOG2E;
constexpr float RMS_EPS = 1e-6f;
constexpr size_t O_Y = 0, O_KP = (size_t)MT * DM, O_VP = O_KP + (size_t)MP * KVW, O_PP = O_VP + (size_t)MP * KVW, O_KS = O_PP + 15 * PW, O_VS = O_KS + (size_t)MS * KVW,
                 O_PS = O_VS + (size_t)MS * KVW, O_END = O_PS + (size_t)32 * 15 * PW;
constexpr size_t MiB = 1u << 20;
constexpr size_t WS_CTL = 0, CTL_ZERO_BYTES = 1 * MiB;
constexpr size_t WS_WIN = 1 * MiB, WS_WOUT = 73 * MiB, WS_WP = 105 * MiB, WS_XN = 107 * MiB, WS_Q = 173 * MiB, WS_GA = 206 * MiB, WS_U = 239 * MiB, WS_GP = 272 * MiB, WS_ZP = 305 * MiB,
                 WS_K = 338 * MiB, WS_V = 347 * MiB, WS_MIX = 356 * MiB, WS_CMEAN = 422 * MiB, WS_LP = 424 * MiB, WS_LS = 440 * MiB, WS_PO = 441 * MiB, WS_PL = 540 * MiB, WS_SSQ = 542 * MiB,
                 WS_END = 545 * MiB;
constexpr int CW_TMO = 0, CW_BAR = 256, CW_CNTP = 8192, CW_CNTS = 8448, CW_KMS = 16384;
constexpr int LP_CAP = 32768;
constexpr int RING_BYTES = 131072, LDSCTL_OFF = 152576, LDS_BYTES = 153600;
constexpr int ATT_KV = 0, ATT_TAB = 65536, TABN = 3104, TAB_NEG = 128, ATT_WS = ATT_TAB + 4 * TABN * 4  , ATT_RB = ATT_WS + 2048  , ATT_MISC = ATT_RB + 2048  , ATT_OST = 119808;
static_assert(ATT_MISC + 512 <= ATT_OST && ATT_OST + 32768 <= LDSCTL_OFF && LDSCTL_OFF + 1024 <= LDS_BYTES, "attention LDS map");

#define LDS_WAIT() asm volatile("s_waitcnt lgkmcnt(0)" ::: "memory")
#define VM_WAIT() asm volatile("s_waitcnt vmcnt(0)" ::: "memory")
__device__ __forceinline__ unsigned cvt_pk_bf16(float lo, float hi) { unsigned r; asm volatile("v_cvt_pk_bf16_f32 %0, %1, %2" : "=v"(r) : "v"(lo), "v"(hi)); return r; }
__device__ __forceinline__ float bf2f(unsigned short b) { return __uint_as_float(((unsigned)b) << 16); }
__device__ __forceinline__ float bflo(unsigned w) { return __uint_as_float(w << 16); }
__device__ __forceinline__ float bfhi(unsigned w) { return __uint_as_float(w & 0xffff0000u); }
__device__ __forceinline__ float silu_f(float x) { return x * __builtin_amdgcn_rcpf(1.0f + __builtin_amdgcn_exp2f(-x * LOG2E)); }
__device__ __forceinline__ float wave_sum(float v) {
#pragma unroll
    for (int o = 1; o < 64; o <<= 1) v += __shfl_xor(v, o);
    return v;
}

namespace pg8 {
#define PG8_LAS __attribute__((address_space(3)))
typedef unsigned short bf16_t;
constexpr int BM = 256, BK = 64, HALF = 128, HTB = HALF * BK * 2, STAGE_BYTES = 8 * HTB, NXCD = 8, WGM = 8;
__host__ __device__ __forceinline__ int lds_byte(int r, int c) { const int st = (r >> 4) * 2 + (c >> 5), rr = r & 15, cc = c & 31, ob = rr * 64 + cc * 2; return st * 1024 + (ob ^ (((ob >> 9) & 1) << 5)); }
__host__ __device__ __forceinline__ void stage_rc(int b, int& R, int& C) { const int st = b / 1024, sb = b % 1024, swz = sb ^ (((sb >> 9) & 1) << 5); R = (st >> 1) * 16 + swz / 64; C = (st & 1) * 32 + (swz % 64) / 2; }
__host__ __device__ __forceinline__ int perm32(int rho) { const int n = rho >> 4, i = rho & 15; return 8 * (i >> 2) + 4 * n + (i & 3); }
struct Unit { int pm, pn; };
struct Gemm { const bf16_t* A; const bf16_t* Bt; int M, N, K, lda, ldb, grp_shift, grp_acol; };
struct StaticOrder {
    int nM, nN, nwg, G, c;
    __device__ void init(int M, int N, int G_, int c_) { nM = M / BM; nN = N / BM; nwg = nM * nN; G = G_; c = c_; }
    __device__ bool next(int i, Unit& u) const {
        const long L = (long)i * G + c; if (L >= nwg) return false;
        int wgid = (int)L; { const int q = nwg / NXCD, r = nwg % NXCD, xcd = wgid % NXCD, off = wgid / NXCD; wgid = (xcd < r ? xcd * (q + 1) : r * (q + 1) + (xcd - r) * q) + off; }
        const int nig = WGM * nN, gid = wgid / nig, fm = gid * WGM, gsz = (nM - fm) < WGM ? (nM - fm) : WGM;
        u.pm = fm + ((wgid % nig) % gsz); u.pn = (wgid % nig) / gsz; return true;
    }
};
template <class Epi>
__device__ __forceinline__ void gemm_phase(PG8_LAS unsigned char* lds, const Gemm g, const StaticOrder& S, const Epi& E) {
    const int tid = threadIdx.x, wid = __builtin_amdgcn_readfirstlane(tid >> 6), lane = tid & 63, wr = wid >> 2, wc = wid & 3, fr = lane & 15, fq = lane >> 4;
    const int K = g.K, nt = K / BK;
    unsigned voffA[2], voffB[2];
#pragma unroll
    for (int i = 0; i < 2; ++i) { int R, C; stage_rc(tid * 16 + i * 8192, R, C); const int Rb = (R & ~31) + perm32(R & 31);
        voffA[i] = (unsigned)(R * g.lda + C) * 2u; voffB[i] = (unsigned)(Rb * g.ldb + C) * 2u; }
    const size_t kstep = (size_t)(BK * 2);
    const size_t hstepA = (size_t)HALF * g.lda * 2, hstepB = (size_t)HALF * g.ldb * 2;
    const size_t tstepA = 2 * hstepA, tstepB = 2 * hstepB;
    const unsigned ldsw = (unsigned)wid * 1024u;
    const int aoff = lds_byte(wr * 64 + fr, fq * 8), boff = lds_byte(wc * 32 + fr, fq * 8);
#define PG8_SA(b, h) (((b) * 2 + (h)) * HTB)
#define PG8_SB(b, h) ((4 + (b) * 2 + (h)) * HTB)
#define PG8_STAGE(bufoff, gbase, voff) do { _Pragma("unroll") for (int _i = 0; _i < 2; ++_i) \
        __builtin_amdgcn_global_load_lds((const unsigned*)((const char*)(gbase) + (voff)[_i]), (PG8_LAS unsigned*)(lds + (bufoff) + ldsw + _i * 8192), 16, 0, 0); } while (0)
#define PG8_LDA(dst, b, h) do { _Pragma("unroll") for (int m = 0; m < 4; ++m) _Pragma("unroll") for (int k = 0; k < 2; ++k) dst[m][k] = *(const PG8_LAS bf16x8*)(lds + PG8_SA(b, h) + aoff + m * 2048 + k * 1024); } while (0)
#define PG8_LDB(dst, b, h) do { _Pragma("unroll") for (int n = 0; n < 2; ++n) _Pragma("unroll") for (int k = 0; k < 2; ++k) dst[n][k] = *(const PG8_LAS bf16x8*)(lds + PG8_SB(b, h) + boff + n * 2048 + k * 1024); } while (0)
#define PG8_MMA(ai, bj, At, Bt) do { __builtin_amdgcn_s_setprio(1); _Pragma("unroll") for (int m = 0; m < 4; ++m) _Pragma("unroll") for (int n = 0; n < 2; ++n) _Pragma("unroll") for (int k = 0; k < 2; ++k) \
        acc[ai][bj][m][n] = __builtin_amdgcn_mfma_f32_16x16x32_bf16(Bt[n][k], At[m][k], acc[ai][bj][m][n], 0, 0, 0); __builtin_amdgcn_s_setprio(0); } while (0)
#define PG8_WAIT_V(n) asm volatile("s_waitcnt vmcnt(" #n ")" ::: "memory")
#define PG8_WAIT_L(n) asm volatile("s_waitcnt lgkmcnt(" #n ")" ::: "memory")
#define PG8_BAR __builtin_amdgcn_s_barrier()
#define PG8_SCHED __builtin_amdgcn_sched_barrier(0)
#define PG8_APTR(u) ((const char*)g.A + (size_t)(u).pm * tstepA + (size_t)(((u).pn >> g.grp_shift) * g.grp_acol) * 2)
#define PG8_BPTR(u) ((const char*)g.Bt + (size_t)(u).pn * tstepB)
    Unit cur, nxt; int ui = 0;
    if (!S.next(0, cur)) return;
    f32x4 acc[2][2][4][2];
#pragma unroll
    for (int a = 0; a < 2; ++a)
#pragma unroll
        for (int b = 0; b < 2; ++b)
#pragma unroll
            for (int m = 0; m < 4; ++m)
#pragma unroll
                for (int n = 0; n < 2; ++n) acc[a][b][m][n] = (f32x4){0.f, 0.f, 0.f, 0.f};
    bf16x8 At[4][2], B0[2][2], B1[2][2];
    const char* cA = PG8_APTR(cur); const char* cB = PG8_BPTR(cur);
    PG8_STAGE(PG8_SB(0, 0), cB, voffB); PG8_STAGE(PG8_SB(0, 1), cB + hstepB, voffB); PG8_STAGE(PG8_SA(0, 0), cA, voffA); PG8_STAGE(PG8_SA(0, 1), cA + hstepA, voffA);
    if (wr == 1) PG8_BAR;
    PG8_WAIT_V(2); PG8_BAR;
    PG8_STAGE(PG8_SB(1, 0), cB + kstep, voffB); PG8_STAGE(PG8_SA(1, 0), cA + kstep, voffA); PG8_STAGE(PG8_SB(1, 1), cB + hstepB + kstep, voffB);
    PG8_WAIT_V(6); PG8_BAR;
    for (;;) {
        const bool has_next = S.next(ui + 1, nxt);
        const char* nA = has_next ? PG8_APTR(nxt) : cA; const char* nB = has_next ? PG8_BPTR(nxt) : cB;
        for (int t = 0; t < nt; t += 2) {
            const bool last = (t == nt - 2);
            const char* a1 = cA + (size_t)(t + 1) * kstep;
            const char* a2 = last ? nA : cA + (size_t)(t + 2) * kstep; const char* b2 = last ? nB : cB + (size_t)(t + 2) * kstep;
            const char* a3 = a2 + kstep; const char* b3 = b2 + kstep;
            PG8_LDB(B0, 0, 0); PG8_LDB(B1, 0, 1); PG8_SCHED; PG8_LDA(At, 0, 0); PG8_STAGE(PG8_SA(1, 1), a1 + hstepA, voffA);
            PG8_WAIT_V(8); PG8_WAIT_L(0); PG8_BAR; PG8_MMA(0, 0, At, B0); PG8_MMA(0, 1, At, B1); PG8_BAR; PG8_SCHED;
            PG8_LDA(At, 0, 1); PG8_STAGE(PG8_SB(0, 0), b2, voffB); PG8_STAGE(PG8_SB(0, 1), b2 + hstepB, voffB); PG8_STAGE(PG8_SA(0, 0), a2, voffA);
            PG8_WAIT_V(8); PG8_WAIT_L(0); PG8_BAR; PG8_MMA(1, 0, At, B0); PG8_MMA(1, 1, At, B1); PG8_BAR; PG8_SCHED;
            PG8_LDB(B0, 1, 0); PG8_LDB(B1, 1, 1); PG8_SCHED; PG8_LDA(At, 1, 0); PG8_STAGE(PG8_SA(0, 1), a2 + hstepA, voffA);
            PG8_WAIT_V(8); PG8_WAIT_L(0); PG8_BAR; PG8_MMA(0, 0, At, B0); PG8_MMA(0, 1, At, B1); PG8_BAR; PG8_SCHED;
            PG8_LDA(At, 1, 1); PG8_STAGE(PG8_SB(1, 0), b3, voffB); PG8_STAGE(PG8_SB(1, 1), b3 + hstepB, voffB); PG8_STAGE(PG8_SA(1, 0), a3, voffA);
            PG8_WAIT_V(8); PG8_WAIT_L(0); PG8_BAR; PG8_MMA(1, 0, At, B0); PG8_MMA(1, 1, At, B1); PG8_BAR; PG8_SCHED;
        }
        if (wr == 0) PG8_BAR;
        E(acc, cur, wr, wc, fr, fq);
        if (!has_next) break;
#pragma unroll
        for (int a = 0; a < 2; ++a)
#pragma unroll
            for (int b = 0; b < 2; ++b)
#pragma unroll
                for (int m = 0; m < 4; ++m)
#pragma unroll
                    for (int n = 0; n < 2; ++n) acc[a][b][m][n] = (f32x4){0.f, 0.f, 0.f, 0.f};
        cur = nxt; cA = nA; cB = nB; ++ui;
        if (wr == 1) PG8_BAR;
    }
    PG8_WAIT_V(0);
    PG8_BAR;
#undef PG8_SA
#undef PG8_SB
#undef PG8_STAGE
#undef PG8_LDA
#undef PG8_LDB
#undef PG8_MMA
#undef PG8_WAIT_V
#undef PG8_WAIT_L
#undef PG8_BAR
#undef PG8_SCHED
#undef PG8_APTR
#undef PG8_BPTR
}
}

#define XB_TMO      128
#define XB_XCNT(j)  (256  + 64 * (j))
#define XB_XSUB(j)  (1280 + 64 * (j))
#define XB_XGEN(j)  (2304 + 64 * (j))
#define XB_TOP      3328
#define XB_TOPGEN   3392
#define XCD_BAR_WORDS 3456
#define XB_SPIN_CAP (1u << 18)
__device__ __forceinline__ unsigned xb_ld(unsigned* p)              { return __hip_atomic_load(p, __ATOMIC_RELAXED, __HIP_MEMORY_SCOPE_AGENT); }
__device__ __forceinline__ unsigned xb_add(unsigned* p, unsigned v) { return __hip_atomic_fetch_add(p, v, __ATOMIC_RELAXED, __HIP_MEMORY_SCOPE_AGENT); }
__device__ __forceinline__ unsigned xb_xcc_id() { return (unsigned)__builtin_amdgcn_s_getreg((3 << 11) | 20) & 0xFu; }
#define XB_SPIN(cond, bar) do { unsigned _sp = 0; while (cond) { __builtin_amdgcn_s_sleep(1); \
    if ((++_sp & 255u) == 0u) { if (xb_ld(&(bar)[XB_TMO])) break; if (_sp > XB_SPIN_CAP) { atomicAdd(&(bar)[XB_TMO], 1u); break; } } } } while (0)
struct XcdBarrier { unsigned* bar; unsigned x; volatile LAS unsigned* st; };
__device__ __forceinline__ XcdBarrier xcd_barrier_post(unsigned* bar, volatile LAS unsigned* st) {
    XcdBarrier b; b.bar = bar; b.x = xb_xcc_id(); b.st = st;
    if (threadIdx.x == 0) (void)xb_add(&bar[XB_XCNT(b.x)], 1u);
    return b;
}
__device__ __forceinline__ void xcd_barrier_complete(unsigned* bar, unsigned x, unsigned& nloc, unsigned& nx) {
    const unsigned G = gridDim.x * gridDim.y * gridDim.z;
    unsigned sum, cnt, mine, sp = 0u;
    for (;;) {
        sum = 0u; cnt = 0u; mine = 0u;
#pragma unroll
        for (unsigned j = 0; j < 16; ++j) { const unsigned c = xb_ld(&bar[XB_XCNT(j)]); sum += c; cnt += (c > 0u) ? 1u : 0u; mine = (j == x) ? c : mine; }
        if (sum == G) break;
        __builtin_amdgcn_s_sleep(1);
        if ((++sp & 255u) == 0u) { if (xb_ld(&bar[XB_TMO])) break; if (sp > XB_SPIN_CAP) { atomicAdd(&bar[XB_TMO], 1u); break; } }
    }
    nloc = mine > 0u ? mine : 1u; nx = cnt > 0u ? cnt : 1u;
}
__device__ __forceinline__ void xcd_barrier(const XcdBarrier& b) {
    asm volatile("s_waitcnt vmcnt(0)" ::: "memory");
    __syncthreads();
    if (threadIdx.x == 0) {
        unsigned* bar = b.bar;
        __builtin_amdgcn_s_waitcnt(0);
        unsigned nloc = b.st[0], nx = b.st[1];
        if (nloc == 0u) { xcd_barrier_complete(bar, b.x, nloc, nx); b.st[0] = nloc; b.st[1] = nx; }
        const unsigned old = xb_add(&bar[XB_XSUB(b.x)], 1u);
        const unsigned gen = old / nloc;
        if (old + 1u == (gen + 1u) * nloc) {
            __builtin_amdgcn_fence(__ATOMIC_RELEASE, "agent");
            asm volatile("s_waitcnt vmcnt(0)" ::: "memory");
            const unsigned og = xb_add(&bar[XB_TOP], 1u);
            const unsigned tg = og / nx;
            if (og + 1u == (tg + 1u) * nx) xb_add(&bar[XB_TOPGEN], 1u);
            else XB_SPIN(xb_ld(&bar[XB_TOPGEN]) == tg, bar);
            __builtin_amdgcn_fence(__ATOMIC_ACQUIRE, "agent");
            xb_add(&bar[XB_XGEN(b.x)], 1u);
            asm volatile("s_waitcnt vmcnt(0)" ::: "memory");
        } else {
            XB_SPIN(xb_ld(&bar[XB_XGEN(b.x)]) == gen, bar);
            __builtin_amdgcn_fence(__ATOMIC_ACQUIRE, "agent");
            asm volatile("s_waitcnt vmcnt(0)" ::: "memory");
        }
    }
    __syncthreads();
}

struct Params {
    const float *x_p, *x_s, *cache_k, *cache_v, *state_pool; const int* page_table;
    const float *norm_in, *w_in, *w_pool, *pool_scale, *w_out, *rel_bias, *norm_out;
    float* out; unsigned char* ws; int ph_lo, ph_hi, li, pad;
};

__device__ __forceinline__ unsigned f2bf(float f) { unsigned u = __builtin_bit_cast(unsigned, f); return (u + 0x7fffu + ((u >> 16) & 1u)) >> 16; }
__device__ __forceinline__ unsigned pk2(float lo, float hi) { return f2bf(lo) | (f2bf(hi) << 16); }
__device__ __forceinline__ void p0_transpose_item(const float* W, int K, int N, bf16* WT, LAS float* scr, int item, int lane) {
    const int nblk = N / 32, kb = item / nblk, nb = item % nblk, k0 = 64 * kb, n0 = 32 * nb;
#pragma unroll 8
    for (int i = 0; i < 32; ++i) { const int kk = 2 * i + (lane >> 5); scr[kk * 33 + (lane & 31)] = W[(size_t)(k0 + kk) * N + n0 + (lane & 31)]; }
    LDS_WAIT(); asm volatile("" ::: "memory");
    const int c = lane & 7;
#pragma unroll
    for (int j = 0; j < 4; ++j) { const int n = (lane >> 3) + 8 * j; const LAS float* s = scr + (8 * c) * 33 + n;
        v4u o; o.x = pk2(s[0 * 33], s[1 * 33]); o.y = pk2(s[2 * 33], s[3 * 33]); o.z = pk2(s[4 * 33], s[5 * 33]); o.w = pk2(s[6 * 33], s[7 * 33]);
        *(v4u*)(WT + (size_t)(n0 + n) * K + k0 + 8 * c) = o; }
    LDS_WAIT(); asm volatile("" ::: "memory");
}
__device__ __forceinline__ void rms_row_to_bf16(const float* xrow, const float* gain, bf16* orow, int lane) {
    const f32x4* xr = (const f32x4*)xrow + lane; const f32x4* gr = (const f32x4*)gain + lane;
    f32x4 v[16]; float s = 0.f;
#pragma unroll
    for (int j = 0; j < 16; ++j) { v[j] = xr[64 * j]; s += (v[j].x * v[j].x + v[j].y * v[j].y) + (v[j].z * v[j].z + v[j].w * v[j].w); }
    const float rstd = 1.0f / sqrtf(wave_sum(s) * (1.f / DM) + RMS_EPS);
    v2u* o8 = (v2u*)orow + lane;
#pragma unroll
    for (int j = 0; j < 16; ++j) { const f32x4 g = gr[64 * j]; v2u w; w.x = cvt_pk_bf16(v[j].x * rstd * g.x, v[j].y * rstd * g.y); w.y = cvt_pk_bf16(v[j].z * rstd * g.z, v[j].w * rstd * g.w); o8[64 * j] = w; }
}

typedef const f32x4 (&AccRef)[2][2][4][2];
template <int ACT> __device__ __forceinline__ void epi_store_bf16(AccRef acc, bf16* base, int ldc) {
#pragma unroll
    for (int ai = 0; ai < 2; ++ai)
#pragma unroll
        for (int m = 0; m < 4; ++m) { bf16* rowp = base + (size_t)(ai * 128 + m * 16) * ldc;
#pragma unroll
            for (int bj = 0; bj < 2; ++bj) { f32x4 v0 = acc[ai][bj][m][0], v1 = acc[ai][bj][m][1];
                if (ACT == 1) {
#pragma unroll
                    for (int e = 0; e < 4; ++e) { v0[e] = silu_f(v0[e]); v1[e] = silu_f(v1[e]); } }
                v4u w; w.x = cvt_pk_bf16(v0[0], v0[1]); w.y = cvt_pk_bf16(v0[2], v0[3]); w.z = cvt_pk_bf16(v1[0], v1[1]); w.w = cvt_pk_bf16(v1[2], v1[3]);
                *(v4u*)(rowp + bj * 128) = w; } }
}
struct EpiIn {
    bf16 *Q, *Kb, *Vb, *GA, *Ub, *GP; float* out; float* kms;
    __device__ __forceinline__ void operator()(AccRef acc, const pg8::Unit& u, int wr, int wc, int fr, int fq) const {
        const int pn = u.pn, pm = u.pm, row0 = pm * 256 + wr * 64 + fr, cw = wc * 32 + 8 * fq;
        if (pn < 8) { epi_store_bf16<0>(acc, Q + (size_t)row0 * AW + pn * 256 + cw, AW); }
        else if (pn < 12) {
            const int which = (pn - 8) >> 1, cl = ((pn - 8) & 1) * 256 + cw;
            bf16* ob = (which ? Vb : Kb) + (size_t)row0 * KVW + cl;
            epi_store_bf16<0>(acc, ob, KVW);
            float* of = (pm < 32) ? out + (which ? O_VP : O_KP) + (size_t)row0 * KVW + cl : out + (which ? O_VS : O_KS) + (size_t)(row0 - MP) * KVW + cl;
#pragma unroll
            for (int ai = 0; ai < 2; ++ai)
#pragma unroll
                for (int m = 0; m < 4; ++m) { float* rowp = of + (size_t)(ai * 128 + m * 16) * KVW;
#pragma unroll
                    for (int bj = 0; bj < 2; ++bj) { *(f32x4*)(rowp + bj * 128) = acc[ai][bj][m][0]; *(f32x4*)(rowp + bj * 128 + 4) = acc[ai][bj][m][1]; } }
            if (which == 0 && pm < 32) {
#pragma unroll
                for (int bj = 0; bj < 2; ++bj)
#pragma unroll
                    for (int n = 0; n < 2; ++n) { f32x4 s = (f32x4){0.f, 0.f, 0.f, 0.f};
#pragma unroll
                        for (int ai = 0; ai < 2; ++ai)
#pragma unroll
                            for (int m = 0; m < 4; ++m) s += acc[ai][bj][m][n];
#pragma unroll
                        for (int e = 0; e < 4; ++e) { float x = s[e]; x += __shfl_xor(x, 1); x += __shfl_xor(x, 2); x += __shfl_xor(x, 4); x += __shfl_xor(x, 8); s[e] = x; }
                        if (fr == 0) {
#pragma unroll
                            for (int e = 0; e < 4; ++e) __hip_atomic_fetch_add(kms + pm * KVW + cl + bj * 128 + 4 * n + e, s[e], __ATOMIC_RELAXED, __HIP_MEMORY_SCOPE_AGENT); } }
            }
        }
        else if (pn < 20) { epi_store_bf16<1>(acc, GA + (size_t)row0 * AW + (pn - 12) * 256 + cw, AW); }
        else if (pn < 28) {
            const int cl = (pn - 20) * 256 + cw;
            epi_store_bf16<0>(acc, Ub + (size_t)row0 * PW + cl, PW);
            if (pm >= 31) {
#pragma unroll
                for (int ai = 0; ai < 2; ++ai)
#pragma unroll
                    for (int m = 0; m < 4; ++m) { const int r = row0 + ai * 128 + m * 16; float* rowp = nullptr;
                        if (pm == 31) { if (r >= MP - 15) rowp = out + O_PP + (size_t)(r - (MP - 15)) * PW + cl; }
                        else { const int rs = r - MP; rowp = out + O_PS + (size_t)((rs >> 3) * 15 + 7 + (rs & 7)) * PW + cl; }
                        if (rowp) {
#pragma unroll
                            for (int bj = 0; bj < 2; ++bj) { *(f32x4*)(rowp + bj * 128) = acc[ai][bj][m][0]; *(f32x4*)(rowp + bj * 128 + 4) = acc[ai][bj][m][1]; } } }
            }
        }
        else { epi_store_bf16<1>(acc, GP + (size_t)row0 * PW + (pn - 28) * 256 + cw, PW); }
    }
};
struct EpiPool {
    const bf16* GP; const float* scale; bf16* MIX;
    __device__ __forceinline__ void operator()(AccRef acc, const pg8::Unit& u, int wr, int wc, int fr, int fq) const {
        const int row0 = u.pm * 256 + wr * 64 + fr, col0 = u.pn * 256 + wc * 32 + 8 * fq;
        f32x4 sc[2][2];
#pragma unroll
        for (int bj = 0; bj < 2; ++bj) { sc[bj][0] = *(const f32x4*)(scale + col0 + bj * 128); sc[bj][1] = *(const f32x4*)(scale + col0 + bj * 128 + 4); }
#pragma unroll
        for (int ai = 0; ai < 2; ++ai)
#pragma unroll
            for (int m = 0; m < 4; ++m) { const size_t r = (size_t)(row0 + ai * 128 + m * 16);
#pragma unroll
                for (int bj = 0; bj < 2; ++bj) { const v4u g = *(const v4u*)(GP + r * PW + col0 + bj * 128);
                    const f32x4 v0 = acc[ai][bj][m][0] * sc[bj][0], v1 = acc[ai][bj][m][1] * sc[bj][1];
                    v4u w; w.x = cvt_pk_bf16(v0[0] * bflo(g.x), v0[1] * bfhi(g.x)); w.y = cvt_pk_bf16(v0[2] * bflo(g.y), v0[3] * bfhi(g.y));
                    w.z = cvt_pk_bf16(v1[0] * bflo(g.z), v1[1] * bfhi(g.z)); w.w = cvt_pk_bf16(v1[2] * bflo(g.w), v1[3] * bfhi(g.w));
                    *(v4u*)(MIX + r * DM + AW + col0 + bj * 128) = w; } }
    }
};
struct EpiOut {
    const float *x_p, *x_s; float* Y; float* ssq;
    __device__ __forceinline__ void operator()(AccRef acc, const pg8::Unit& u, int wr, int wc, int fr, int fq) const {
        const int row0 = u.pm * 256 + wr * 64 + fr, col0 = u.pn * 256 + wc * 32 + 8 * fq;
        const float* xb = (u.pm < 32) ? x_p + (size_t)row0 * DM : x_s + (size_t)(row0 - MP) * DM;
#pragma unroll
        for (int ai = 0; ai < 2; ++ai)
#pragma unroll
            for (int m = 0; m < 4; ++m) { const size_t ro = (size_t)(ai * 128 + m * 16) * DM + col0; float ss = 0.f;
#pragma unroll
                for (int bj = 0; bj < 2; ++bj) {
                    const f32x4 h0 = acc[ai][bj][m][0] + *(const f32x4*)(xb + ro + bj * 128), h1 = acc[ai][bj][m][1] + *(const f32x4*)(xb + ro + bj * 128 + 4);
                    *(f32x4*)(Y + (size_t)row0 * DM + ro + bj * 128) = h0; *(f32x4*)(Y + (size_t)row0 * DM + ro + bj * 128 + 4) = h1;
                    ss += (h0[0] * h0[0] + h0[1] * h0[1]) + (h0[2] * h0[2] + h0[3] * h0[3]) + (h1[0] * h1[0] + h1[1] * h1[1]) + (h1[2] * h1[2] + h1[3] * h1[3]); }
                ss += __shfl_xor(ss, 16); ss += __shfl_xor(ss, 32);
                if (fq == 0) ssq[(size_t)(row0 + ai * 128 + m * 16) * 64 + u.pn * 4 + wc] = ss; }
    }
};

#define KSWZ(row, colB) ((row) * 256 + ((colB) ^ (((row) & 7) << 4)))
#define SBAR() __builtin_amdgcn_sched_barrier(0)
__device__ __forceinline__ int crow(int r, int hi) { return (r & 3) + 8 * (r >> 2) + 4 * hi; }
__device__ __forceinline__ int v_st(int k, int c) { const int kk = (k & ~0xC) | ((k & 4) << 1) | ((k & 8) >> 1); return ((kk >> 3) * 4 + (c >> 5)) * 512 + ((kk & 7) * 32 + (c & 31)) * 2; }
__device__ __forceinline__ int v_rd_base(int lane) { return ((lane & 3) << 3) | (((lane >> 2) & 3) << 6) | (((lane >> 4) & 1) << 5) | (((lane >> 5) & 1) << 8); }
constexpr int v_rd_off(int d0, int ks, int half) { return d0 * 512 + ks * 4096 + half * 2048; }
template <int OFF> __device__ __forceinline__ s16x4 tr_read(int vb) { s16x4 r; asm volatile("ds_read_b64_tr_b16 %0, %1 offset:%2" : "=&v"(r) : "v"(vb), "i"(OFF) : "memory"); return r; }
template <int D0> __device__ __forceinline__ void pv_one(f32x16& od, int vb, bf16x8 pa0, bf16x8 pa1, bf16x8 pa2, bf16x8 pa3) {
    const s16x4 l0 = tr_read<v_rd_off(D0, 0, 0)>(vb), h0 = tr_read<v_rd_off(D0, 0, 1)>(vb), l1 = tr_read<v_rd_off(D0, 1, 0)>(vb), h1 = tr_read<v_rd_off(D0, 1, 1)>(vb);
    const s16x4 l2 = tr_read<v_rd_off(D0, 2, 0)>(vb), h2 = tr_read<v_rd_off(D0, 2, 1)>(vb), l3 = tr_read<v_rd_off(D0, 3, 0)>(vb), h3 = tr_read<v_rd_off(D0, 3, 1)>(vb);
    asm volatile("s_waitcnt lgkmcnt(0)" ::: "memory"); SBAR();
#define PKV(L, H) (bf16x8){L[0], L[1], L[2], L[3], H[0], H[1], H[2], H[3]}
    od = __builtin_amdgcn_mfma_f32_32x32x16_bf16(pa0, PKV(l0, h0), od, 0, 0, 0);
    od = __builtin_amdgcn_mfma_f32_32x32x16_bf16(pa1, PKV(l1, h1), od, 0, 0, 0);
    od = __builtin_amdgcn_mfma_f32_32x32x16_bf16(pa2, PKV(l2, h2), od, 0, 0, 0);
    od = __builtin_amdgcn_mfma_f32_32x32x16_bf16(pa3, PKV(l3, h3), od, 0, 0, 0);
#undef PKV
}
__device__ __forceinline__ void qkt(f32x16& p0, f32x16& p1, const LAS char* Ks, const bf16x8 (&qr)[8], int r32, int hi) {
#pragma unroll
    for (int r = 0; r < 16; ++r) { p0[r] = 0.f; p1[r] = 0.f; }
#pragma unroll
    for (int d0 = 0; d0 < 8; ++d0) { const int cb = (d0 * 16 + hi * 8) * 2;
        const bf16x8 b0 = *(const LAS bf16x8*)(Ks + KSWZ(r32, cb));
        const bf16x8 b1 = *(const LAS bf16x8*)(Ks + KSWZ(32 + r32, cb));
        p0 = __builtin_amdgcn_mfma_f32_32x32x16_bf16(b0, qr[d0], p0, 0, 0, 0);
        p1 = __builtin_amdgcn_mfma_f32_32x32x16_bf16(b1, qr[d0], p1, 0, 0, 0); }
}
__device__ __forceinline__ int rel_bucket_i(int n) {
    if (n < 16) return n;
    const int e = 31 - __clz(n); const unsigned long long n2 = (unsigned long long)n * (unsigned long long)n;
    const int b = 2 * e + (int)((n2 >> (2 * e + 1)) != 0ull) + 8; return b > 31 ? 31 : b;
}
struct KVPrompt { const bf16* K; const bf16* V;
    struct Regs { bf16x8 k0, k1, v0, v1; };
    __device__ __forceinline__ void load(int t, Regs& R, int tid) const {
        const int sr = tid >> 4, sc = (tid & 15) * 8; const size_t o = (size_t)(64 * t + sr) * KVW + sc;
        R.k0 = *(const bf16x8*)(K + o); R.k1 = *(const bf16x8*)(K + o + 32 * KVW); R.v0 = *(const bf16x8*)(V + o); R.v1 = *(const bf16x8*)(V + o + 32 * KVW); }
    __device__ __forceinline__ static void write(const Regs& R, LAS char* Kl, LAS char* Vl, int tid) {
        const int sr = tid >> 4, sc = (tid & 15) * 8;
        *(LAS bf16x8*)(Kl + KSWZ(sr, sc * 2)) = R.k0; *(LAS bf16x8*)(Kl + KSWZ(32 + sr, sc * 2)) = R.k1;
        *(LAS bf16x8*)(Vl + v_st(sr, sc)) = R.v0; *(LAS bf16x8*)(Vl + v_st(32 + sr, sc)) = R.v1; } };
struct KVPaged { const float* ck; const float* cv; const int* pt;
    struct Regs { f32x4 a[8]; };
    __device__ __forceinline__ void load(int t, Regs& R, int tid) const {
        const int sr = tid >> 4, sc = (tid & 15) * 8; const int page = pt[t >> 1];
        const size_t o = ((size_t)page * 128 + 64 * (t & 1) + sr) * KVW + sc;
        R.a[0] = __builtin_nontemporal_load((const f32x4*)(ck + o)); R.a[1] = __builtin_nontemporal_load((const f32x4*)(ck + o + 4));
        R.a[2] = __builtin_nontemporal_load((const f32x4*)(ck + o + 32 * KVW)); R.a[3] = __builtin_nontemporal_load((const f32x4*)(ck + o + 32 * KVW + 4));
        R.a[4] = __builtin_nontemporal_load((const f32x4*)(cv + o)); R.a[5] = __builtin_nontemporal_load((const f32x4*)(cv + o + 4));
        R.a[6] = __builtin_nontemporal_load((const f32x4*)(cv + o + 32 * KVW)); R.a[7] = __builtin_nontemporal_load((const f32x4*)(cv + o + 32 * KVW + 4)); }
    __device__ __forceinline__ static void write(const Regs& R, LAS char* Kl, LAS char* Vl, int tid) {
        const int sr = tid >> 4, sc = (tid & 15) * 8;
        v4u w[4];
#pragma unroll
        for (int i = 0; i < 4; ++i) { w[i].x = cvt_pk_bf16(R.a[2 * i][0], R.a[2 * i][1]); w[i].y = cvt_pk_bf16(R.a[2 * i][2], R.a[2 * i][3]); w[i].z = cvt_pk_bf16(R.a[2 * i + 1][0], R.a[2 * i + 1][1]); w[i].w = cvt_pk_bf16(R.a[2 * i + 1][2], R.a[2 * i + 1][3]); }
        *(LAS v4u*)(Kl + KSWZ(sr, sc * 2)) = w[0]; *(LAS v4u*)(Kl + KSWZ(32 + sr, sc * 2)) = w[1];
        *(LAS v4u*)(Vl + v_st(sr, sc)) = w[2]; *(LAS v4u*)(Vl + v_st(32 + sr, sc)) = w[3]; } };

template <bool CAUSAL>
__device__ __forceinline__ void attn_tile(LAS char* lds, const LAS char* Kl, const LAS char* Vl, const bf16x8 (&qr)[8], int dq, int hl, float& m_reg, float& l_reg, f32x16 (&o)[4], int wid, int lane) {
    const int r32 = lane & 31, hi = lane >> 5;
    LAS float* al_l = (LAS float*)(lds + ATT_WS + wid * 256);
    const LAS float* tab = (const LAS float*)(lds + ATT_TAB) + hl * TABN;
    const int vb = (int)(unsigned)(size_t)Vl + v_rd_base(lane);
    f32x16 p0, p1;
    qkt(p0, p1, Kl, qr, r32, hi);
    const int dqc = dq < 2960 ? dq : 2960;
    const LAS float* tb = tab + (dqc + TAB_NEG - 63 - 4 * hi);
#pragma unroll
    for (int r = 0; r < 16; ++r) { const int k0 = (r & 3) + 8 * (r >> 2);
        p0[r] = fmaf(p0[r], C_SC, tb[63 - k0]); p1[r] = fmaf(p1[r], C_SC, tb[31 - k0]);
        if (CAUSAL) { if (k0 + 4 * hi > dq) p0[r] = -1e30f; if (32 + k0 + 4 * hi > dq) p1[r] = -1e30f; } }
    float pmax = p0[0];
#pragma unroll
    for (int r = 1; r < 16; ++r) pmax = fmaxf(pmax, p0[r]);
#pragma unroll
    for (int r = 0; r < 16; ++r) pmax = fmaxf(pmax, p1[r]);
    { auto rr = __builtin_amdgcn_permlane32_swap(__float_as_uint(pmax), __float_as_uint(pmax), false, false); pmax = fmaxf(__uint_as_float(rr[0]), __uint_as_float(rr[1])); }
    const float mn = fmaxf(m_reg, pmax), alpha = __builtin_amdgcn_exp2f(m_reg - mn); m_reg = mn;
    float ps = 0.f;
#pragma unroll
    for (int r = 0; r < 16; ++r) { p0[r] = __builtin_amdgcn_exp2f(p0[r] - mn); p1[r] = __builtin_amdgcn_exp2f(p1[r] - mn); ps += p0[r] + p1[r]; }
    { auto rr = __builtin_amdgcn_permlane32_swap(__float_as_uint(ps), __float_as_uint(ps), false, false); ps = __uint_as_float(rr[0]) + __uint_as_float(rr[1]); }
    l_reg = l_reg * alpha + ps;
    bf16x8 pa0, pa1, pa2, pa3;
#define PK4(P, BASE, OUT) do { unsigned a0 = cvt_pk_bf16(P[BASE + 0], P[BASE + 1]), a1 = cvt_pk_bf16(P[BASE + 2], P[BASE + 3]); \
        unsigned b0 = cvt_pk_bf16(P[BASE + 4], P[BASE + 5]), b1 = cvt_pk_bf16(P[BASE + 6], P[BASE + 7]); \
        auto r0 = __builtin_amdgcn_permlane32_swap(a0, b0, false, false); auto r1 = __builtin_amdgcn_permlane32_swap(a1, b1, false, false); \
        v4u w = {r0[0], r1[0], r0[1], r1[1]}; OUT = *reinterpret_cast<bf16x8*>(&w); } while (0)
    PK4(p0, 0, pa0); PK4(p0, 8, pa1); PK4(p1, 0, pa2); PK4(p1, 8, pa3);
#undef PK4
    if (__any(alpha < 1.f)) {
        if (hi == 0) al_l[r32] = alpha;
        LDS_WAIT();
#pragma unroll
        for (int r = 0; r < 16; ++r) { const float a = al_l[crow(r, hi)];
#pragma unroll
            for (int d = 0; d < 4; ++d) o[d][r] *= a; }
    }
    pv_one<0>(o[0], vb, pa0, pa1, pa2, pa3); pv_one<1>(o[1], vb, pa0, pa1, pa2, pa3); pv_one<2>(o[2], vb, pa0, pa1, pa2, pa3); pv_one<3>(o[3], vb, pa0, pa1, pa2, pa3);
}
__device__ __forceinline__ void put_inv_l(LAS char* lds, float l_reg, int wid, int lane) {
    LAS float* al_l = (LAS float*)(lds + ATT_WS + wid * 256);
    if ((lane >> 5) == 0) al_l[lane & 31] = 1.0f / l_reg;
    LDS_WAIT();
}
__device__ __forceinline__ void stage_o_half(LAS char* lds, const f32x16 (&o)[4], int hh, int wid, int lane) {
    const int r32 = lane & 31, hi = lane >> 5;
    const LAS float* al_l = (const LAS float*)(lds + ATT_WS + wid * 256);
    LAS bf16* Os = (LAS bf16*)(lds + ATT_OST + wid * 4096);
#pragma unroll
    for (int r = 0; r < 16; ++r) { const int row = crow(r, hi); const float inv = al_l[row];
        Os[row * 64 + r32] = (bf16)f2bf((hh ? o[2][r] : o[0][r]) * inv); Os[row * 64 + 32 + r32] = (bf16)f2bf((hh ? o[3][r] : o[1][r]) * inv); }
    LDS_WAIT();
}
__device__ __forceinline__ void build_bias_table(LAS char* lds, const float* rel_bias, int kvh, int tid) {
    LAS float* rb = (LAS float*)(lds + ATT_RB); LAS float* tab = (LAS float*)(lds + ATT_TAB);
    rb[tid] = rel_bias[tid] * LOG2E;
    __syncthreads();
    for (int e = tid; e < 4 * TABN; e += 512) { const int hl = e / TABN, i = e - hl * TABN; int d = i - TAB_NEG; d = d < 0 ? 0 : d;
        tab[e] = rb[rel_bucket_i(d) * NH + kvh * 4 + hl]; }
}
struct RowInfo { const bf16* qp; int dq0, hl; bool valid, active; size_t oidx; };
struct PolPrompt {
    typedef KVPrompt Src;
    const unsigned* LP; const bf16 *Qb, *Kb, *Vb; bf16* PO; float* PL; const LAS int* pref; const LAS int* cnt; int kvh, gsub, ngsub, nitems;
    __device__ __forceinline__ void locate(int k, int& j, int& tile) const { const int it = gsub + k * ngsub; int jj = 0; while (pref[jj + 1] <= it) ++jj; j = jj; tile = it - pref[jj]; }
    __device__ __forceinline__ Src src(int k) const { int j, tile; locate(k, j, tile); return Src{Kb + (size_t)(256 * j) * KVW + kvh * 128, Vb + (size_t)(256 * j) * KVW + kvh * 128}; }
    __device__ __forceinline__ unsigned entry(int k, int wid, int lane) const { int j, tile; locate(k, j, tile); const int idx = tile * 256 + wid * 32 + (lane & 31);
        return idx < cnt[j] ? LP[(size_t)(kvh * 32 + j) * LP_CAP + idx] : 0x80000000u; }
    __device__ __forceinline__ RowInfo rows(int k, unsigned ent, int wid, int lane) const { int j, tile; locate(k, j, tile);
        const int q = ent & 8191, hl = (ent >> 13) & 3, s = (ent >> 15) & 3; RowInfo r; r.valid = !(ent >> 31); r.hl = hl;
        r.qp = Qb + (size_t)q * AW + (kvh * 4 + hl) * 128 + (lane >> 5) * 8; r.dq0 = r.valid ? q - 256 * j : 4096; r.active = wid * 32 < cnt[j] - tile * 256;
        r.oidx = ((size_t)q * NH + kvh * 4 + hl) * 3 + s; return r; }
};
struct PolSample {
    typedef KVPaged Src;
    const unsigned* LS; const bf16* Qb; const float *ck, *cv; const int* pt; bf16* PO; float* PL; const LAS int* items; const LAS int* cnts; int kvh, nitems;
    __device__ __forceinline__ Src src(int k) const { const int si = items[k], b = si >> 5, j = si & 31; return Src{ck + kvh * 128, cv + kvh * 128, pt + b * 64 + 2 * j}; }
    __device__ __forceinline__ unsigned entry(int k, int wid, int lane) const { const int si = items[k], b = si >> 5, j = si & 31, idx = wid * 32 + (lane & 31);
        return idx < cnts[k] ? LS[((size_t)b * 128 + kvh * 32 + j) * 32 + idx] : 0x80000000u; }
    __device__ __forceinline__ RowInfo rows(int k, unsigned ent, int wid, int lane) const { const int si = items[k], b = si >> 5, j = si & 31;
        const int t = ent & 7, hl = (ent >> 3) & 3, s = (ent >> 5) & 3, row = MP + b * 8 + t; RowInfo r; r.valid = !(ent >> 31); r.hl = hl;
        r.qp = Qb + (size_t)row * AW + (kvh * 4 + hl) * 128 + (lane >> 5) * 8; r.dq0 = r.valid ? MP + t - 256 * j : 4096; r.active = wid * 32 < cnts[k];
        r.oidx = ((size_t)row * NH + kvh * 4 + hl) * 3 + s; return r; }
};
struct PolOwn {
    typedef KVPrompt Src;
    const bf16 *Qb, *Kb, *Vb; int kvh, gsub, ngsub, nitems;
    __device__ __forceinline__ Src src(int k) const { const int b = (gsub + k * ngsub) >> 2; return Src{Kb + (size_t)(256 * b) * KVW + kvh * 128, Vb + (size_t)(256 * b) * KVW + kvh * 128}; }
    __device__ __forceinline__ unsigned entry(int, int, int) const { return 0u; }
    __device__ __forceinline__ RowInfo rows(int k, unsigned, int wid, int lane) const { const int it = gsub + k * ngsub, b = it >> 2, hl = it & 3, ql = wid * 32 + (lane & 31);
        RowInfo r; r.valid = true; r.active = true; r.hl = hl; r.dq0 = ql; r.qp = Qb + (size_t)(256 * b + ql) * AW + (kvh * 4 + hl) * 128 + (lane >> 5) * 8; r.oidx = (size_t)it; return r; }
};
template <bool CAUSAL, class Pol, class Fin>
__device__ __forceinline__ void attn_stream(LAS char* lds, const Pol& pol, const Fin& fin, int tid, int wid, int lane) {
    const int n = pol.nitems;
    if (n <= 0) return;
    typename Pol::Src src = pol.src(0); typename Pol::Src::Regs R;
    src.load(0, R, tid);
    unsigned ent_next = pol.entry(0, wid, lane);
    Pol::Src::write(R, lds + ATT_KV, lds + ATT_KV + 16384, tid);
    __syncthreads();
    for (int k = 0; k < n; ++k) {
        const RowInfo ri = pol.rows(k, ent_next, wid, lane);
        bf16x8 qr[8];
#pragma unroll
        for (int d0 = 0; d0 < 8; ++d0) qr[d0] = *(const bf16x8*)(ri.qp + d0 * 16);
        const bool more_items = (k + 1 < n);
        if (more_items) ent_next = pol.entry(k + 1, wid, lane);
        const typename Pol::Src nsrc = more_items ? pol.src(k + 1) : src;
        float m_reg = -1e30f, l_reg = 0.f; f32x16 o[4];
#pragma unroll
        for (int d = 0; d < 4; ++d)
#pragma unroll
            for (int r = 0; r < 16; ++r) o[d][r] = 0.f;
#pragma unroll
        for (int t = 0; t < 4; ++t) {
            LAS char* Kc = lds + ATT_KV + (t & 1) * 32768; LAS char* Kn = lds + ATT_KV + ((t + 1) & 1) * 32768;
            if (t < 3) src.load(t + 1, R, tid); else if (more_items) nsrc.load(0, R, tid);
            if (ri.active && (!CAUSAL || 64 * t <= 32 * wid + 31)) attn_tile<CAUSAL>(lds, Kc, Kc + 16384, qr, ri.dq0 - 64 * t, ri.hl, m_reg, l_reg, o, wid, lane);
            if (t < 3 || more_items) Pol::Src::write(R, Kn, Kn + 16384, tid);
            __syncthreads();
        }
        fin(k, ri, m_reg, l_reg, o);
        src = nsrc;
    }
}
struct FinPartial { LAS char* lds; bf16* PO; float* PL; int wid, lane;
    __device__ __forceinline__ void operator()(int, const RowInfo& ri, float m_reg, float l_reg, const f32x16 (&o)[4]) const {
        if (!ri.active) return;
        put_inv_l(lds, l_reg, wid, lane);
        if (ri.valid && (lane >> 5) == 0) PL[ri.oidx] = m_reg + __builtin_amdgcn_logf(l_reg);
        const int rr = lane >> 1, q2 = lane & 1;
        const int pv = __shfl((int)ri.valid, rr); const unsigned plo = __shfl((unsigned)ri.oidx, rr);
#pragma unroll
        for (int hh = 0; hh < 2; ++hh) {
            stage_o_half(lds, o, hh, wid, lane);
            if (pv) { const LAS v4u* srow = (const LAS v4u*)(lds + ATT_OST + wid * 4096 + rr * 128 + q2 * 64); v4u* dst = (v4u*)(PO + (size_t)plo * 128 + hh * 64 + q2 * 32);
#pragma unroll
                for (int c = 0; c < 4; ++c) dst[c] = srow[c]; }
            LDS_WAIT();
        }
    }
};
struct FinMerge { LAS char* lds; const bf16* PO; const float* PL; const bf16* GA; bf16* MIX; int kvh, wid, lane;
    __device__ __forceinline__ void operator()(int, const RowInfo& ri, float m_reg, float l_reg, const f32x16 (&o)[4]) const {
        const int it = (int)ri.oidx, b = it >> 2, h = kvh * 4 + (it & 3);
        put_inv_l(lds, l_reg, wid, lane);
        const float lse_own_l = m_reg + __builtin_amdgcn_logf(l_reg);
        const int rr = lane >> 1, q2 = lane & 1, qq = 256 * b + wid * 32 + rr;
        const float lse_own = __shfl(lse_own_l, rr);
        const int nv = b < 3 ? b : 3; const size_t pbase = ((size_t)qq * NH + h) * 3;
        float ls[3], wsl[3]; float M = lse_own;
#pragma unroll
        for (int s = 0; s < 3; ++s) { ls[s] = (s < nv) ? PL[pbase + s] : -1e30f; M = fmaxf(M, ls[s]); }
        const float w_own = __builtin_amdgcn_exp2f(lse_own - M); float W = w_own;
#pragma unroll
        for (int s = 0; s < 3; ++s) { wsl[s] = (s < nv) ? __builtin_amdgcn_exp2f(ls[s] - M) : 0.f; W += wsl[s]; }
        const float invW = 1.0f / W;
#pragma unroll
        for (int hh = 0; hh < 2; ++hh) {
            stage_o_half(lds, o, hh, wid, lane);
            const LAS v4u* srow = (const LAS v4u*)(lds + ATT_OST + wid * 4096 + rr * 128 + q2 * 64);
            const int dcol = h * 128 + hh * 64 + q2 * 32;
            const v4u* ga = (const v4u*)(GA + (size_t)qq * AW + dcol); v4u* dst = (v4u*)(MIX + (size_t)qq * DM + dcol);
#pragma unroll
            for (int c = 0; c < 4; ++c) { const v4u a = srow[c]; float f[8] = {bflo(a.x) * w_own, bfhi(a.x) * w_own, bflo(a.y) * w_own, bfhi(a.y) * w_own, bflo(a.z) * w_own, bfhi(a.z) * w_own, bflo(a.w) * w_own, bfhi(a.w) * w_own};
#pragma unroll
                for (int s = 0; s < 3; ++s) if (s < nv) { const v4u p = *((const v4u*)(PO + (pbase + s) * 128 + hh * 64 + q2 * 32) + c); const float ww = wsl[s];
                    f[0] += ww * bflo(p.x); f[1] += ww * bfhi(p.x); f[2] += ww * bflo(p.y); f[3] += ww * bfhi(p.y); f[4] += ww * bflo(p.z); f[5] += ww * bfhi(p.z); f[6] += ww * bflo(p.w); f[7] += ww * bfhi(p.w); }
                const v4u g = ga[c]; v4u w;
                w.x = cvt_pk_bf16(f[0] * invW * bflo(g.x), f[1] * invW * bfhi(g.x)); w.y = cvt_pk_bf16(f[2] * invW * bflo(g.y), f[3] * invW * bfhi(g.y));
                w.z = cvt_pk_bf16(f[4] * invW * bflo(g.z), f[5] * invW * bfhi(g.z)); w.w = cvt_pk_bf16(f[6] * invW * bflo(g.w), f[7] * invW * bfhi(g.w));
                dst[c] = w; }
            LDS_WAIT();
        }
    }
};
template <int W> __device__ __forceinline__ void pool_task(const bf16* Ub, const float* state_pool, bf16* ZP, int rb, int col) {
    constexpr int NX = 8 + W - 1;
    v4u x[NX];
    const bool smp = rb >= MP / 8; const int r0 = rb * 8, b = rb - MP / 8;
#pragma unroll
    for (int i = 0; i < NX; ++i) { const int off = i - (W - 1);
        if (!smp) { x[i] = (r0 + off >= 0) ? *(const v4u*)(Ub + (size_t)(r0 + off) * PW + col) : (v4u){0u, 0u, 0u, 0u}; }
        else if (off >= 0) x[i] = *(const v4u*)(Ub + (size_t)(r0 + off) * PW + col);
        else { const float* sp = state_pool + (size_t)(b * 15 + 15 + off) * PW + col; const f32x4 a = *(const f32x4*)sp, c = *(const f32x4*)(sp + 4);
            x[i].x = cvt_pk_bf16(a.x, a.y); x[i].y = cvt_pk_bf16(a.z, a.w); x[i].z = cvt_pk_bf16(c.x, c.y); x[i].w = cvt_pk_bf16(c.z, c.w); } }
    float s[8];
#pragma unroll
    for (int e = 0; e < 8; ++e) s[e] = 0.f;
#pragma unroll
    for (int i = 0; i < W - 1; ++i) { s[0] += bflo(x[i].x); s[1] += bfhi(x[i].x); s[2] += bflo(x[i].y); s[3] += bfhi(x[i].y); s[4] += bflo(x[i].z); s[5] += bfhi(x[i].z); s[6] += bflo(x[i].w); s[7] += bfhi(x[i].w); }
#pragma unroll
    for (int k = 0; k < 8; ++k) { const v4u c = x[k + W - 1], old = x[k];
        const float u[8] = {bflo(c.x), bfhi(c.x), bflo(c.y), bfhi(c.y), bflo(c.z), bfhi(c.z), bflo(c.w), bfhi(c.w)};
#pragma unroll
        for (int e = 0; e < 8; ++e) s[e] += u[e];
        const int cnt = smp ? W : ((r0 + k + 1) < W ? (r0 + k + 1) : W); const float inv = 1.0f / (float)cnt;
        v4u ov; ov.x = cvt_pk_bf16(s[0] * inv - u[0], s[1] * inv - u[1]); ov.y = cvt_pk_bf16(s[2] * inv - u[2], s[3] * inv - u[3]);
        ov.z = cvt_pk_bf16(s[4] * inv - u[4], s[5] * inv - u[5]); ov.w = cvt_pk_bf16(s[6] * inv - u[6], s[7] * inv - u[7]);
        *(v4u*)(ZP + (size_t)(r0 + k) * PW + col) = ov;
        s[0] -= bflo(old.x); s[1] -= bfhi(old.x); s[2] -= bflo(old.y); s[3] -= bfhi(old.y); s[4] -= bflo(old.z); s[5] -= bfhi(old.z); s[6] -= bflo(old.w); s[7] -= bfhi(old.w); }
}


__global__ void __launch_bounds__(512, 2) moba_fwd(Params P) {
    extern __shared__ __attribute__((aligned(16))) unsigned char lds_raw[];
    LAS unsigned char* lds = (LAS unsigned char*)lds_raw;
    LAS char* ldc = (LAS char*)lds_raw;
    const int tid = threadIdx.x, lane = tid & 63, wid = __builtin_amdgcn_readfirstlane(tid >> 6);
    const int G = gridDim.x, bid = blockIdx.x;
    unsigned char* ws = P.ws;
    unsigned* ctl = (unsigned*)(ws + WS_CTL);
    bf16* WinT = (bf16*)(ws + WS_WIN); bf16* WoutT = (bf16*)(ws + WS_WOUT); bf16* WpT = (bf16*)(ws + WS_WP); bf16* XN = (bf16*)(ws + WS_XN);
    bf16* Qb = (bf16*)(ws + WS_Q); bf16* GA = (bf16*)(ws + WS_GA); bf16* Ub = (bf16*)(ws + WS_U); bf16* GP = (bf16*)(ws + WS_GP); bf16* ZP = (bf16*)(ws + WS_ZP);
    bf16* Kb = (bf16*)(ws + WS_K); bf16* Vb = (bf16*)(ws + WS_V); bf16* MIX = (bf16*)(ws + WS_MIX);
    float* CMEAN = (float*)(ws + WS_CMEAN); unsigned* LP = (unsigned*)(ws + WS_LP); unsigned* LS = (unsigned*)(ws + WS_LS);
    bf16* PO = (bf16*)(ws + WS_PO); float* PL = (float*)(ws + WS_PL); float* SSQ = (float*)(ws + WS_SSQ);
    float* KMS = (float*)(ctl + CW_KMS); unsigned* cntP = ctl + CW_CNTP; unsigned* cntS = ctl + CW_CNTS;

    for (int u = tid; u < (LDS_BYTES - LDSCTL_OFF) / 4; u += 512) ((LAS unsigned*)(lds + LDSCTL_OFF))[u] = 0u;
    __syncthreads();
    volatile LAS unsigned* MISC = (volatile LAS unsigned*)(lds + LDSCTL_OFF + 320);
    const int lo = P.ph_lo, hi_ph = P.ph_hi;
    XcdBarrier bar; bar.bar = ctl + CW_BAR; bar.x = 0; bar.st = nullptr;
    if (MK_N_LAUNCHES == 1) bar = xcd_barrier_post(ctl + CW_BAR + P.li * XCD_BAR_WORDS, MISC + 8);
#define IN(k) (lo <= (k) && (k) < hi_ph)
#define SEAM(k) do { if (MK_N_LAUNCHES == 1 && IN(k) && IN((k) + 1)) xcd_barrier(bar); } while (0)

    if (IN(0)) {
        LAS float* scr = (LAS float*)(lds + wid * 16384);
        const int gw = bid * 8 + wid, NGW = G * 8;
        constexpr int I_IN = (DM / 64) * (NIN / 32), I_OUT = (DM / 64) * (DM / 32), I_PG = (512 / 64) * (512 / 32);
        for (int it = gw; it < I_IN + I_OUT + 4 * I_PG; it += NGW) {
            int r = it;
            if (r < I_IN) { p0_transpose_item(P.w_in, DM, NIN, WinT, scr, r, lane); continue; } r -= I_IN;
            if (r < I_OUT) { p0_transpose_item(P.w_out, DM, DM, WoutT, scr, r, lane); continue; } r -= I_OUT;
            const int g = r / I_PG; p0_transpose_item(P.w_pool + (size_t)g * 512 * 512, 512, 512, WpT + (size_t)g * 512 * 512, scr, r - g * I_PG, lane);
        }
        for (int m = gw; m < MT; m += NGW) rms_row_to_bf16(m < MP ? P.x_p + (size_t)m * DM : P.x_s + (size_t)(m - MP) * DM, P.norm_in, XN + (size_t)m * DM, lane);
        __syncthreads();
        {
            LAS f32x4* red = (LAS f32x4*)lds;
            const int c4 = tid & 127, rg = tid >> 7;
            for (int it = bid; it < 32 * 32; it += G) {
                const int b = it >> 5, j = it & 31;
                f32x4 acc = (f32x4){0.f, 0.f, 0.f, 0.f};
#pragma unroll
                for (int hpg = 0; hpg < 2; ++hpg) {
                    const int page = P.page_table[b * 64 + 2 * j + hpg];
                    const float* base = P.cache_k + ((size_t)page * 128 + rg) * KVW + c4 * 4;
#pragma unroll 8
                    for (int rr = 0; rr < 32; ++rr) acc += *(const f32x4*)(base + (size_t)(4 * rr) * KVW);
                }
                red[rg * 128 + c4] = acc;
                __syncthreads();
                if (rg == 0) { const f32x4 s = (red[c4] + red[128 + c4]) + (red[256 + c4] + red[384 + c4]); *(f32x4*)(CMEAN + (size_t)it * KVW + c4 * 4) = s * (1.0f / 256.0f); }
                __syncthreads();
            }
        }
    }
    SEAM(0);

    if (IN(1)) {
        pg8::Gemm g{XN, WinT, MT, NIN, DM, DM, DM, 0, 0}; pg8::StaticOrder S; S.init(MT, NIN, G, bid);
        EpiIn E{Qb, Kb, Vb, GA, Ub, GP, P.out, KMS};
        pg8::gemm_phase<EpiIn>(lds, g, S, E);
    }
    SEAM(1);

    if (IN(2)) {
        LAS float* KM = (LAS float*)lds;
        LAS int* cntL = (LAS int*)(lds + 65536); LAS int* baseL = cntL + 128; LAS int* SELL = baseL + 128; LAS int* LPL = SELL + 32 * 48;
        const int h = lane >> 2, part = lane & 3, kvh = h >> 2;
        for (int ch = bid; ch < 256 + 32; ch += G) {
            const bool smp = ch >= 256; const int b_s = ch - 256;
            const int nblk = smp ? 32 : (ch >> 3);
            const int nvalid = nblk < 3 ? nblk : 3;
            __syncthreads();
            if (smp) { for (int e = tid; e < 32 * 128; e += 512) ((LAS f32x4*)KM)[e] = *(const f32x4*)(CMEAN + (size_t)b_s * 32 * KVW + e * 4); }
            else { for (int e = tid; e < nblk * 128; e += 512) ((LAS f32x4*)KM)[e] = *(const f32x4*)(KMS + e * 4) * (1.0f / 256.0f); }
            if (tid < 128) cntL[tid] = 0;
            __syncthreads();
            const int nrow = smp ? 1 : 4;
            for (int i = 0; i < nrow; ++i) {
                const int rl = smp ? wid : wid * 4 + i;
                const int r = smp ? MP + b_s * 8 + wid : ch * 32 + rl;
                float q[32];
                { const v4u* qp = (const v4u*)(Qb + (size_t)r * AW + h * 128 + part * 32);
#pragma unroll
                  for (int c = 0; c < 4; ++c) { const v4u w = qp[c]; q[8 * c + 0] = bflo(w.x); q[8 * c + 1] = bfhi(w.x); q[8 * c + 2] = bflo(w.y); q[8 * c + 3] = bfhi(w.y);
                      q[8 * c + 4] = bflo(w.z); q[8 * c + 5] = bfhi(w.z); q[8 * c + 6] = bflo(w.w); q[8 * c + 7] = bfhi(w.w); } }
                float v0 = -3.0e38f, v1 = -3.0e38f, v2 = -3.0e38f; int i0 = 0, i1 = 0, i2 = 0;
                for (int n = 0; n < nblk; ++n) {
                    const LAS f32x4* km = (const LAS f32x4*)(KM + n * KVW + kvh * 128 + part * 32);
                    float a = 0.f;
#pragma unroll
                    for (int c = 0; c < 8; ++c) { const f32x4 k4 = km[c]; a = fmaf(q[4 * c], k4.x, a); a = fmaf(q[4 * c + 1], k4.y, a); a = fmaf(q[4 * c + 2], k4.z, a); a = fmaf(q[4 * c + 3], k4.w, a); }
                    a += __shfl_xor(a, 1); a += __shfl_xor(a, 2);
                    if (a > v0) { v2 = v1; i2 = i1; v1 = v0; i1 = i0; v0 = a; i0 = n; }
                    else if (a > v1) { v2 = v1; i2 = i1; v1 = a; i1 = n; }
                    else if (a > v2) { v2 = a; i2 = n; }
                }
                if (part == 0) {
                    const int e0 = (rl * 16 + h) * 3;
                    if (nvalid > 0) { SELL[e0] = i0; LPL[e0] = __hip_atomic_fetch_add(&cntL[kvh * 32 + i0], 1, __ATOMIC_RELAXED, __HIP_MEMORY_SCOPE_WORKGROUP); }
                    if (nvalid > 1) { SELL[e0 + 1] = i1; LPL[e0 + 1] = __hip_atomic_fetch_add(&cntL[kvh * 32 + i1], 1, __ATOMIC_RELAXED, __HIP_MEMORY_SCOPE_WORKGROUP); }
                    if (nvalid > 2) { SELL[e0 + 2] = i2; LPL[e0 + 2] = __hip_atomic_fetch_add(&cntL[kvh * 32 + i2], 1, __ATOMIC_RELAXED, __HIP_MEMORY_SCOPE_WORKGROUP); }
                }
            }
            __syncthreads();
            if (tid < 128) { const int c = cntL[tid];
                if (smp) { baseL[tid] = 0; cntS[b_s * 128 + tid] = (unsigned)c; }
                else baseL[tid] = c ? (int)__hip_atomic_fetch_add(cntP + tid, (unsigned)c, __ATOMIC_RELAXED, __HIP_MEMORY_SCOPE_AGENT) : 0; }
            __syncthreads();
            const int nent = (smp ? 8 : 32) * 48;
            for (int e = tid; e < nent; e += 512) { const int s = e % 3; if (s >= nvalid) continue;
                const int hh = (e / 3) & 15, rl = e / 48, j = SELL[e], lp = LPL[e], li = (hh >> 2) * 32 + j;
                if (smp) LS[((size_t)b_s * 128 + li) * 32 + lp] = (unsigned)(rl | ((hh & 3) << 3) | (s << 5));
                else LP[(size_t)li * LP_CAP + baseL[li] + lp] = (unsigned)((ch * 32 + rl) | ((hh & 3) << 13) | (s << 15)); }
        }
        for (int task = bid * 512 + tid; task < (MT / 8) * 256; task += G * 512) {
            const int rb = task >> 8, col = (task & 255) * 8;
            switch (col >> 9) { case 0: pool_task<2>(Ub, P.state_pool, ZP, rb, col); break; case 1: pool_task<4>(Ub, P.state_pool, ZP, rb, col); break;
                                case 2: pool_task<8>(Ub, P.state_pool, ZP, rb, col); break; default: pool_task<16>(Ub, P.state_pool, ZP, rb, col); break; }
        }
        for (int e = bid * 512 + tid; e < 32 * 7 * (PW / 4); e += G * 512) { const int c4 = e % (PW / 4), rr = (e / (PW / 4)) % 7, b = e / (7 * (PW / 4));
            *(f32x4*)(P.out + O_PS + (size_t)(b * 15 + rr) * PW + c4 * 4) = *(const f32x4*)(P.state_pool + (size_t)(b * 15 + 8 + rr) * PW + c4 * 4); }
    }
    SEAM(2);

    if (IN(3)) {
        {
            pg8::Gemm g{ZP, WpT, MT, PW, 512, PW, 512, 1, 512}; pg8::StaticOrder S; S.init(MT, PW, G, bid);
            EpiPool E{GP, P.pool_scale, MIX};
            pg8::gemm_phase<EpiPool>(lds, g, S, E);
        }
        const int kvh = bid & 3, gsub = bid >> 2, ngsub = G >> 2;
        __syncthreads();
        build_bias_table(ldc, P.rel_bias, kvh, tid);
        LAS int* pref = (LAS int*)(lds + ATT_MISC); LAS int* cntl = pref + 40; LAS int* sitems = cntl + 32; LAS int* scnts = sitems + 24; LAS int* nsi = scnts + 24;
        if (tid == 0) { int a = 0; for (int j = 0; j < 32; ++j) { const int c = (int)cntP[kvh * 32 + j]; cntl[j] = c; pref[j] = a; a += (c + 255) >> 8; } pref[32] = a;
            int ns = 0; for (int si = gsub; si < 1024; si += ngsub) { const int c = (int)cntS[(si >> 5) * 128 + kvh * 32 + (si & 31)]; if (c > 0) { sitems[ns] = si; scnts[ns] = c; ++ns; } } *nsi = ns; }
        __syncthreads();
        {
            const int npi = pref[32];
            PolPrompt pol{LP, Qb, Kb, Vb, PO, PL, pref, cntl, kvh, gsub, ngsub, npi > gsub ? (npi - gsub + ngsub - 1) / ngsub : 0};
            FinPartial fin{ldc, PO, PL, wid, lane};
            attn_stream<false, PolPrompt, FinPartial>(ldc, pol, fin, tid, wid, lane);
        }
        {
            PolSample pol{LS, Qb, P.cache_k, P.cache_v, P.page_table, PO, PL, sitems, scnts, kvh, *nsi};
            FinPartial fin{ldc, PO, PL, wid, lane};
            attn_stream<false, PolSample, FinPartial>(ldc, pol, fin, tid, wid, lane);
        }
    }
    SEAM(3);

    if (IN(4)) {
        const int kvh = bid & 3, gsub = bid >> 2, ngsub = G >> 2;
        __syncthreads();
        build_bias_table(ldc, P.rel_bias, kvh, tid);
        __syncthreads();
        {
            PolOwn pol{Qb, Kb, Vb, kvh, gsub, ngsub, 128 > gsub ? (128 - gsub + ngsub - 1) / ngsub : 0};
            FinMerge fin{ldc, PO, PL, GA, MIX, kvh, wid, lane};
            attn_stream<true, PolOwn, FinMerge>(ldc, pol, fin, tid, wid, lane);
        }
        for (int task = bid * 8 + wid; task < MS * NH; task += G * 8) {
            const int h = task & 15, rs = task >> 4, b = rs >> 3, t = rs & 7, row = MP + rs, kv = h >> 2;
            const unsigned qw = *(const unsigned*)(Qb + (size_t)row * AW + h * 128 + 2 * lane); const float q0 = bflo(qw), q1 = bfhi(qw);
            float x[8], vx[8], vy[8]; const size_t pbase = ((size_t)row * NH + h) * 3;
            float M = fmaxf(fmaxf(PL[pbase], PL[pbase + 1]), PL[pbase + 2]);
#pragma unroll
            for (int tp = 0; tp < 8; ++tp) { x[tp] = -1e30f; vx[tp] = 0.f; vy[tp] = 0.f;
                if (tp <= t) { const size_t ko = (size_t)(MP + b * 8 + tp) * KVW + kv * 128 + 2 * lane; const unsigned kw = *(const unsigned*)(Kb + ko), vw = *(const unsigned*)(Vb + ko);
                    x[tp] = wave_sum(q0 * bflo(kw) + q1 * bfhi(kw)) * C_SC + P.rel_bias[(t - tp) * NH + h] * LOG2E; vx[tp] = bflo(vw); vy[tp] = bfhi(vw); M = fmaxf(M, x[tp]); } }
            float W = 0.f, a0 = 0.f, a1 = 0.f;
#pragma unroll
            for (int tp = 0; tp < 8; ++tp) { const float w = (tp <= t) ? __builtin_amdgcn_exp2f(x[tp] - M) : 0.f; W += w; a0 += w * vx[tp]; a1 += w * vy[tp]; }
#pragma unroll
            for (int s = 0; s < 3; ++s) { const float w = __builtin_amdgcn_exp2f(PL[pbase + s] - M); const unsigned pw = *(const unsigned*)(PO + (pbase + s) * 128 + 2 * lane); W += w; a0 += w * bflo(pw); a1 += w * bfhi(pw); }
            const unsigned gw = *(const unsigned*)(GA + (size_t)row * AW + h * 128 + 2 * lane); const float inv = 1.0f / W;
            *(unsigned*)(MIX + (size_t)row * DM + h * 128 + 2 * lane) = cvt_pk_bf16(a0 * inv * bflo(gw), a1 * inv * bfhi(gw));
        }
    }
    SEAM(4);

    if (IN(5)) {
        pg8::Gemm g{MIX, WoutT, MT, DM, DM, DM, DM, 0, 0}; pg8::StaticOrder S; S.init(MT, DM, G, bid);
        EpiOut E{P.x_p, P.x_s, P.out + O_Y, SSQ};
        pg8::gemm_phase<EpiOut>(lds, g, S, E);
    }
    SEAM(5);

    if (IN(6)) {
        for (int m = bid * 8 + wid; m < MT; m += G * 8) {
            const float ss = wave_sum(SSQ[(size_t)m * 64 + lane]);
            const float rstd = 1.0f / sqrtf(ss * (1.f / DM) + RMS_EPS);
            f32x4* y = (f32x4*)(P.out + O_Y + (size_t)m * DM) + lane; const f32x4* gn = (const f32x4*)P.norm_out + lane;
#pragma unroll
            for (int j = 0; j < 16; ++j) { const f32x4 g = gn[64 * j]; f32x4 v = y[64 * j]; v.x *= rstd * g.x; v.y *= rstd * g.y; v.z *= rstd * g.z; v.w *= rstd * g.w; y[64 * j] = v; }
        }
    }
#undef IN
#undef SEAM
}

extern "C" void kernel_launch(void* const* d_in, const int* in_sizes, int n_in, void* d_out, int out_size, void* d_ws, size_t ws_size, hipStream_t stream) {
    static int grid = 0;
    if (grid == 0) {
        if (n_in != 13 || (size_t)out_size != O_END || ws_size < WS_END) { fprintf(stderr, "kernel_launch: unexpected shapes (n_in %d out %d ws %zu)\n", n_in, out_size, ws_size); grid = -1; return; }
        int dev = 0, cus = 0, per_cu = 0;
        if (hipGetDevice(&dev) != hipSuccess || hipDeviceGetAttribute(&cus, hipDeviceAttributeMultiprocessorCount, dev) != hipSuccess) { grid = -1; return; }
        if (hipFuncSetAttribute((const void*)moba_fwd, hipFuncAttributeMaxDynamicSharedMemorySize, LDS_BYTES) != hipSuccess) { fprintf(stderr, "kernel_launch: hipFuncSetAttribute failed\n"); grid = -1; return; }
        if (hipOccupancyMaxActiveBlocksPerMultiprocessor(&per_cu, (const void*)moba_fwd, 512, LDS_BYTES) != hipSuccess || per_cu < 1) fprintf(stderr, "kernel_launch: occupancy query reports %d\n", per_cu);
        (void)hipGetLastError();
        grid = cus;
        if (grid % 4 != 0) { fprintf(stderr, "kernel_launch: grid %d not a multiple of 4\n", grid); grid = -1; return; }
    }
    if (grid < 0) return;
    (void)hipMemsetAsync((char*)d_ws + WS_CTL, 0, CTL_ZERO_BYTES, stream);
    Params p{};
    p.x_p = (const float*)d_in[0]; p.x_s = (const float*)d_in[1]; p.cache_k = (const float*)d_in[2]; p.cache_v = (const float*)d_in[3]; p.state_pool = (const float*)d_in[4];
    p.page_table = (const int*)d_in[5]; p.norm_in = (const float*)d_in[6]; p.w_in = (const float*)d_in[7]; p.w_pool = (const float*)d_in[8]; p.pool_scale = (const float*)d_in[9];
    p.w_out = (const float*)d_in[10]; p.rel_bias = (const float*)d_in[11]; p.norm_out = (const float*)d_in[12];
    p.out = (float*)d_out; p.ws = (unsigned char*)d_ws;
#if MK_N_LAUNCHES == 1 && PROBE_REP >= 0
    p.ph_lo = 0; p.ph_hi = (PROBE_REP == 5 || PROBE_REP == 6) ? 7 : PROBE_REP + 1; p.li = 0;
    hipLaunchKernelGGL(moba_fwd, dim3(grid), dim3(512), LDS_BYTES, stream, p);
#if PROBE_REP == 1
    (void)hipMemsetAsync((char*)d_ws + WS_CTL + CW_KMS * 4, 0, 32 * 512 * 4, stream);
#elif PROBE_REP == 2
    (void)hipMemsetAsync((char*)d_ws + WS_CTL + CW_CNTP * 4, 0, (CW_KMS - CW_CNTP) * 4, stream);
#endif
    p.ph_lo = PROBE_REP; p.ph_hi = 7; p.li = 1;
    hipLaunchKernelGGL(moba_fwd, dim3(grid), dim3(512), LDS_BYTES, stream, p);
#elif MK_N_LAUNCHES == 1
    p.ph_lo = 0; p.ph_hi = 7;
    hipLaunchKernelGGL(moba_fwd, dim3(grid), dim3(512), LDS_BYTES, stream, p);
#else
    for (int ph = 0; ph < 7; ++ph) { p.ph_lo = ph; p.ph_hi = ph + 1; hipLaunchKernelGGL(moba_fwd, dim3(grid), dim3(512), LDS_BYTES, stream, p); }
#endif
}
```

```cpp
#include <hip/hip_runtime.h>
#include <cstdio>
#include <cstdint>

#ifndef MK_N_LAUNCHES
#define MK_N_LAUNCHES 1
#endif

#ifndef PROBE_REP
#define PROBE_REP -1
#endif
#define GAS __attribute__((address_space(1)))
#define LAS __attribute__((address_space(3)))
typedef unsigned short bf16;
typedef unsigned v4u __attribute__((ext_vector_type(4)));
typedef unsigned v2u __attribute__((ext_vector_type(2)));
typedef float f32x4 __attribute__((ext_vector_type(4)));
typedef float f32x2 __attribute__((ext_vector_type(2)));
typedef float f32x16 __attribute__((ext_vector_type(16)));
typedef short bf16x8 __attribute__((ext_vector_type(8)));
typedef short s16x4 __attribute__((ext_vector_type(4)));

constexpr int MP = 8192, MS = 256, MT = MP + MS, DM = 4096, NIN = 9216, AW = 2048, KVW = 512, PW = 2048, NH = 16;
constexpr float LOG2E = 1.4426950408889634f;
constexpr float C_SC = 0.08838834764831845f * LOG2E;
constexpr float RMS_EPS = 1e-6f;
constexpr size_t O_Y = 0, O_KP = (size_t)MT * DM, O_VP = O_KP + (size_t)MP * KVW, O_PP = O_VP + (size_t)MP * KVW, O_KS = O_PP + 15 * PW, O_VS = O_KS + (size_t)MS * KVW,
                 O_PS = O_VS + (size_t)MS * KVW, O_END = O_PS + (size_t)32 * 15 * PW;
constexpr size_t MiB = 1u << 20;
constexpr size_t WS_CTL = 0, CTL_ZERO_BYTES = 1 * MiB;
constexpr size_t WS_WIN = 1 * MiB, WS_WOUT = 73 * MiB, WS_WP = 105 * MiB, WS_XN = 107 * MiB, WS_Q = 173 * MiB, WS_GA = 206 * MiB, WS_U = 239 * MiB, WS_GP = 272 * MiB, WS_ZP = 305 * MiB,
                 WS_K = 338 * MiB, WS_V = 347 * MiB, WS_MIX = 356 * MiB, WS_CMEAN = 422 * MiB, WS_LP = 424 * MiB, WS_LS = 440 * MiB, WS_PO = 441 * MiB, WS_PL = 540 * MiB, WS_SSQ = 542 * MiB,
                 WS_SLAB = 545 * MiB  , WS_END = 577 * MiB;
constexpr int CW_TMO = 0, CW_BAR = 256, CW_CNTP = 8192, CW_CNTS = 8448, CW_KMS = 16384;
constexpr int LP_CAP = 32768;
constexpr int CM_SPLIT = 192;
constexpr int RING_BYTES = 131072, LDSCTL_OFF = 152576, LDS_BYTES = 153600;
constexpr int ATT_KV = 0, ATT_TAB = 65536, TABN = 3104, TAB_NEG = 128, ATT_WS = ATT_TAB + 4 * TABN * 4  , ATT_RB = ATT_WS + 2048  , ATT_MISC = ATT_RB + 2048  , ATT_OST = 119808;
static_assert(ATT_MISC + 512 <= ATT_OST && ATT_OST + 32768 <= LDSCTL_OFF && LDSCTL_OFF + 1024 <= LDS_BYTES, "attention LDS map");

#define LDS_WAIT() asm volatile("s_waitcnt lgkmcnt(0)" ::: "memory")
#define VM_WAIT() asm volatile("s_waitcnt vmcnt(0)" ::: "memory")
__device__ __forceinline__ unsigned cvt_pk_bf16(float lo, float hi) { unsigned r; asm volatile("v_cvt_pk_bf16_f32 %0, %1, %2" : "=v"(r) : "v"(lo), "v"(hi)); return r; }
__device__ __forceinline__ float bf2f(unsigned short b) { return __uint_as_float(((unsigned)b) << 16); }
__device__ __forceinline__ float bflo(unsigned w) { return __uint_as_float(w << 16); }
__device__ __forceinline__ float bfhi(unsigned w) { return __uint_as_float(w & 0xffff0000u); }
__device__ __forceinline__ float silu_f(float x) { return x * __builtin_amdgcn_rcpf(1.0f + __builtin_amdgcn_exp2f(-x * LOG2E)); }
__device__ __forceinline__ float wave_sum(float v) {
#pragma unroll
    for (int o = 1; o < 64; o <<= 1) v += __shfl_xor(v, o);
    return v;
}

namespace pg8 {
#define PG8_LAS __attribute__((address_space(3)))
typedef unsigned short bf16_t;
constexpr int BM = 256, BK = 64, HALF = 128, HTB = HALF * BK * 2, STAGE_BYTES = 8 * HTB, NXCD = 8, WGM = 8;
__host__ __device__ __forceinline__ int lds_byte(int r, int c) { const int st = (r >> 4) * 2 + (c >> 5), rr = r & 15, cc = c & 31, ob = rr * 64 + cc * 2; return st * 1024 + (ob ^ (((ob >> 9) & 1) << 5)); }
__host__ __device__ __forceinline__ void stage_rc(int b, int& R, int& C) { const int st = b / 1024, sb = b % 1024, swz = sb ^ (((sb >> 9) & 1) << 5); R = (st >> 1) * 16 + swz / 64; C = (st & 1) * 32 + (swz % 64) / 2; }
__host__ __device__ __forceinline__ int perm32(int rho) { const int n = rho >> 4, i = rho & 15; return 8 * (i >> 2) + 4 * n + (i & 3); }
struct Unit { int pm, pn; };
struct Gemm { const bf16_t* A; const bf16_t* Bt; int M, N, K, lda, ldb, grp_shift, grp_acol, b_mask, grp_bcol; };
struct StaticOrder {
    int nM, nN, nwg, G, c;
    __device__ void init(int M, int N, int G_, int c_) { nM = M / BM; nN = N / BM; nwg = nM * nN; G = G_; c = c_; }
    __device__ bool next(int i, Unit& u) const {
        const long L = (long)i * G + c; if (L >= nwg) return false;
        int wgid = (int)L; { const int q = nwg / NXCD, r = nwg % NXCD, xcd = wgid % NXCD, off = wgid / NXCD; wgid = (xcd < r ? xcd * (q + 1) : r * (q + 1) + (xcd - r) * q) + off; }
        const int nig = WGM * nN, gid = wgid / nig, fm = gid * WGM, gsz = (nM - fm) < WGM ? (nM - fm) : WGM;
        u.pm = fm + ((wgid % nig) % gsz); u.pn = (wgid % nig) / gsz; return true;
    }
};
template <class Epi>
__device__ __forceinline__ void gemm_phase(PG8_LAS unsigned char* lds, const Gemm g, const StaticOrder& S, const Epi& E) {
    const int tid = threadIdx.x, wid = __builtin_amdgcn_readfirstlane(tid >> 6), lane = tid & 63, wr = wid >> 2, wc = wid & 3, fr = lane & 15, fq = lane >> 4;
    const int K = g.K, nt = K / BK;
    unsigned voffA[2], voffB[2];
#pragma unroll
    for (int i = 0; i < 2; ++i) { int R, C; stage_rc(tid * 16 + i * 8192, R, C); const int Rb = (R & ~31) + perm32(R & 31);
        voffA[i] = (unsigned)(R * g.lda + C) * 2u; voffB[i] = (unsigned)(Rb * g.ldb + C) * 2u; }
    const size_t kstep = (size_t)(BK * 2);
    const size_t hstepA = (size_t)HALF * g.lda * 2, hstepB = (size_t)HALF * g.ldb * 2;
    const size_t tstepA = 2 * hstepA, tstepB = 2 * hstepB;
    const unsigned ldsw = (unsigned)wid * 1024u;
    const int aoff = lds_byte(wr * 64 + fr, fq * 8), boff = lds_byte(wc * 32 + fr, fq * 8);
#define PG8_SA(b, h) (((b) * 2 + (h)) * HTB)
#define PG8_SB(b, h) ((4 + (b) * 2 + (h)) * HTB)
#define PG8_STAGE(bufoff, gbase, voff) do { _Pragma("unroll") for (int _i = 0; _i < 2; ++_i) \
        __builtin_amdgcn_global_load_lds((const unsigned*)((const char*)(gbase) + (voff)[_i]), (PG8_LAS unsigned*)(lds + (bufoff) + ldsw + _i * 8192), 16, 0, 0); } while (0)
#define PG8_LDA(dst, b, h) do { _Pragma("unroll") for (int m = 0; m < 4; ++m) _Pragma("unroll") for (int k = 0; k < 2; ++k) dst[m][k] = *(const PG8_LAS bf16x8*)(lds + PG8_SA(b, h) + aoff + m * 2048 + k * 1024); } while (0)
#define PG8_LDB(dst, b, h) do { _Pragma("unroll") for (int n = 0; n < 2; ++n) _Pragma("unroll") for (int k = 0; k < 2; ++k) dst[n][k] = *(const PG8_LAS bf16x8*)(lds + PG8_SB(b, h) + boff + n * 2048 + k * 1024); } while (0)
#define PG8_MMA(ai, bj, At, Bt) do { __builtin_amdgcn_s_setprio(1); _Pragma("unroll") for (int m = 0; m < 4; ++m) _Pragma("unroll") for (int n = 0; n < 2; ++n) _Pragma("unroll") for (int k = 0; k < 2; ++k) \
        acc[ai][bj][m][n] = __builtin_amdgcn_mfma_f32_16x16x32_bf16(Bt[n][k], At[m][k], acc[ai][bj][m][n], 0, 0, 0); __builtin_amdgcn_s_setprio(0); } while (0)
#define PG8_WAIT_V(n) asm volatile("s_waitcnt vmcnt(" #n ")" ::: "memory")
#define PG8_WAIT_L(n) asm volatile("s_waitcnt lgkmcnt(" #n ")" ::: "memory")
#define PG8_BAR __builtin_amdgcn_s_barrier()
#define PG8_SCHED __builtin_amdgcn_sched_barrier(0)
#define PG8_APTR(u) ((const char*)g.A + (size_t)(u).pm * tstepA + (size_t)(((u).pn >> g.grp_shift) * g.grp_acol) * 2)
#define PG8_BPTR(u) ((const char*)g.Bt + (size_t)((u).pn & g.b_mask) * tstepB + (size_t)(((u).pn >> g.grp_shift) * g.grp_bcol) * 2)
    Unit cur, nxt; int ui = 0;
    if (!S.next(0, cur)) return;
    f32x4 acc[2][2][4][2];
#pragma unroll
    for (int a = 0; a < 2; ++a)
#pragma unroll
        for (int b = 0; b < 2; ++b)
#pragma unroll
            for (int m = 0; m < 4; ++m)
#pragma unroll
                for (int n = 0; n < 2; ++n) acc[a][b][m][n] = (f32x4){0.f, 0.f, 0.f, 0.f};
    bf16x8 At[4][2], B0[2][2], B1[2][2];
    const char* cA = PG8_APTR(cur); const char* cB = PG8_BPTR(cur);
    PG8_STAGE(PG8_SB(0, 0), cB, voffB); PG8_STAGE(PG8_SB(0, 1), cB + hstepB, voffB); PG8_STAGE(PG8_SA(0, 0), cA, voffA); PG8_STAGE(PG8_SA(0, 1), cA + hstepA, voffA);
    if (wr == 1) PG8_BAR;
    PG8_WAIT_V(2); PG8_BAR;
    PG8_STAGE(PG8_SB(1, 0), cB + kstep, voffB); PG8_STAGE(PG8_SA(1, 0), cA + kstep, voffA); PG8_STAGE(PG8_SB(1, 1), cB + hstepB + kstep, voffB);
    PG8_WAIT_V(6); PG8_BAR;
    for (;;) {
        const bool has_next = S.next(ui + 1, nxt);
        const char* nA = has_next ? PG8_APTR(nxt) : cA; const char* nB = has_next ? PG8_BPTR(nxt) : cB;
        for (int t = 0; t < nt; t += 2) {
            const bool last = (t == nt - 2);
            const char* a1 = cA + (size_t)(t + 1) * kstep;
            const char* a2 = last ? nA : cA + (size_t)(t + 2) * kstep; const char* b2 = last ? nB : cB + (size_t)(t + 2) * kstep;
            const char* a3 = a2 + kstep; const char* b3 = b2 + kstep;
            PG8_LDB(B0, 0, 0); PG8_LDB(B1, 0, 1); PG8_SCHED; PG8_LDA(At, 0, 0); PG8_STAGE(PG8_SA(1, 1), a1 + hstepA, voffA);
            PG8_WAIT_V(8); PG8_WAIT_L(0); PG8_BAR; PG8_MMA(0, 0, At, B0); PG8_MMA(0, 1, At, B1); PG8_BAR; PG8_SCHED;
            PG8_LDA(At, 0, 1); PG8_STAGE(PG8_SB(0, 0), b2, voffB); PG8_STAGE(PG8_SB(0, 1), b2 + hstepB, voffB); PG8_STAGE(PG8_SA(0, 0), a2, voffA);
            PG8_WAIT_V(8); PG8_WAIT_L(0); PG8_BAR; PG8_MMA(1, 0, At, B0); PG8_MMA(1, 1, At, B1); PG8_BAR; PG8_SCHED;
            PG8_LDB(B0, 1, 0); PG8_LDB(B1, 1, 1); PG8_SCHED; PG8_LDA(At, 1, 0); PG8_STAGE(PG8_SA(0, 1), a2 + hstepA, voffA);
            PG8_WAIT_V(8); PG8_WAIT_L(0); PG8_BAR; PG8_MMA(0, 0, At, B0); PG8_MMA(0, 1, At, B1); PG8_BAR; PG8_SCHED;
            PG8_LDA(At, 1, 1); PG8_STAGE(PG8_SB(1, 0), b3, voffB); PG8_STAGE(PG8_SB(1, 1), b3 + hstepB, voffB); PG8_STAGE(PG8_SA(1, 0), a3, voffA);
            PG8_WAIT_V(8); PG8_WAIT_L(0); PG8_BAR; PG8_MMA(1, 0, At, B0); PG8_MMA(1, 1, At, B1); PG8_BAR; PG8_SCHED;
        }
        if (wr == 0) PG8_BAR;
        E(acc, cur, wr, wc, fr, fq);
        if (!has_next) break;
#pragma unroll
        for (int a = 0; a < 2; ++a)
#pragma unroll
            for (int b = 0; b < 2; ++b)
#pragma unroll
                for (int m = 0; m < 4; ++m)
#pragma unroll
                    for (int n = 0; n < 2; ++n) acc[a][b][m][n] = (f32x4){0.f, 0.f, 0.f, 0.f};
        cur = nxt; cA = nA; cB = nB; ++ui;
        if (wr == 1) PG8_BAR;
    }
    PG8_WAIT_V(0);
    PG8_BAR;
#undef PG8_SA
#undef PG8_SB
#undef PG8_STAGE
#undef PG8_LDA
#undef PG8_LDB
#undef PG8_MMA
#undef PG8_WAIT_V
#undef PG8_WAIT_L
#undef PG8_BAR
#undef PG8_SCHED
#undef PG8_APTR
#undef PG8_BPTR
}
}

#define XB_TMO      128
#define XB_XCNT(j)  (256  + 64 * (j))
#define XB_XSUB(j)  (1280 + 64 * (j))
#define XB_XGEN(j)  (2304 + 64 * (j))
#define XB_TOP      3328
#define XB_TOPGEN   3392
#define XCD_BAR_WORDS 3456
#define XB_SPIN_CAP (1u << 18)
__device__ __forceinline__ unsigned xb_ld(unsigned* p)              { return __hip_atomic_load(p, __ATOMIC_RELAXED, __HIP_MEMORY_SCOPE_AGENT); }
__device__ __forceinline__ unsigned xb_add(unsigned* p, unsigned v) { return __hip_atomic_fetch_add(p, v, __ATOMIC_RELAXED, __HIP_MEMORY_SCOPE_AGENT); }
__device__ __forceinline__ unsigned xb_xcc_id() { return (unsigned)__builtin_amdgcn_s_getreg((3 << 11) | 20) & 0xFu; }
#define XB_SPIN(cond, bar) do { unsigned _sp = 0; while (cond) { __builtin_amdgcn_s_sleep(1); \
    if ((++_sp & 255u) == 0u) { if (xb_ld(&(bar)[XB_TMO])) break; if (_sp > XB_SPIN_CAP) { atomicAdd(&(bar)[XB_TMO], 1u); break; } } } } while (0)
struct XcdBarrier { unsigned* bar; unsigned x; volatile LAS unsigned* st; };
__device__ __forceinline__ XcdBarrier xcd_barrier_post(unsigned* bar, volatile LAS unsigned* st) {
    XcdBarrier b; b.bar = bar; b.x = xb_xcc_id(); b.st = st;
    if (threadIdx.x == 0) (void)xb_add(&bar[XB_XCNT(b.x)], 1u);
    return b;
}
__device__ __forceinline__ void xcd_barrier_complete(unsigned* bar, unsigned x, unsigned& nloc, unsigned& nx) {
    const unsigned G = gridDim.x * gridDim.y * gridDim.z;
    unsigned sum, cnt, mine, sp = 0u;
    for (;;) {
        sum = 0u; cnt = 0u; mine = 0u;
#pragma unroll
        for (unsigned j = 0; j < 16; ++j) { const unsigned c = xb_ld(&bar[XB_XCNT(j)]); sum += c; cnt += (c > 0u) ? 1u : 0u; mine = (j == x) ? c : mine; }
        if (sum == G) break;
        __builtin_amdgcn_s_sleep(1);
        if ((++sp & 255u) == 0u) { if (xb_ld(&bar[XB_TMO])) break; if (sp > XB_SPIN_CAP) { atomicAdd(&bar[XB_TMO], 1u); break; } }
    }
    nloc = mine > 0u ? mine : 1u; nx = cnt > 0u ? cnt : 1u;
}
__device__ __forceinline__ void xcd_barrier(const XcdBarrier& b) {
    asm volatile("s_waitcnt vmcnt(0)" ::: "memory");
    __syncthreads();
    if (threadIdx.x == 0) {
        unsigned* bar = b.bar;
        __builtin_amdgcn_s_waitcnt(0);
        unsigned nloc = b.st[0], nx = b.st[1];
        if (nloc == 0u) { xcd_barrier_complete(bar, b.x, nloc, nx); b.st[0] = nloc; b.st[1] = nx; }
        const unsigned old = xb_add(&bar[XB_XSUB(b.x)], 1u);
        const unsigned gen = old / nloc;
        if (old + 1u == (gen + 1u) * nloc) {
            __builtin_amdgcn_fence(__ATOMIC_RELEASE, "agent");
            asm volatile("s_waitcnt vmcnt(0)" ::: "memory");
            const unsigned og = xb_add(&bar[XB_TOP], 1u);
            const unsigned tg = og / nx;
            if (og + 1u == (tg + 1u) * nx) xb_add(&bar[XB_TOPGEN], 1u);
            else XB_SPIN(xb_ld(&bar[XB_TOPGEN]) == tg, bar);
            __builtin_amdgcn_fence(__ATOMIC_ACQUIRE, "agent");
            xb_add(&bar[XB_XGEN(b.x)], 1u);
            asm volatile("s_waitcnt vmcnt(0)" ::: "memory");
        } else {
            XB_SPIN(xb_ld(&bar[XB_XGEN(b.x)]) == gen, bar);
            __builtin_amdgcn_fence(__ATOMIC_ACQUIRE, "agent");
            asm volatile("s_waitcnt vmcnt(0)" ::: "memory");
        }
    }
    __syncthreads();
}

struct Params {
    const float *x_p, *x_s, *cache_k, *cache_v, *state_pool; const int* page_table;
    const float *norm_in, *w_in, *w_pool, *pool_scale, *w_out, *rel_bias, *norm_out;
    float* out; unsigned char* ws; int ph_lo, ph_hi, li, pad;
};

__device__ __forceinline__ unsigned f2bf(float f) { unsigned u = __builtin_bit_cast(unsigned, f); return (u + 0x7fffu + ((u >> 16) & 1u)) >> 16; }
__device__ __forceinline__ unsigned pk2(float lo, float hi) { return f2bf(lo) | (f2bf(hi) << 16); }
__device__ __forceinline__ void p0_transpose_item(const float* W, int K, int N, bf16* WT, LAS float* scr, int item, int lane) {
    const int nblk = N / 32, kb = item / nblk, nb = item % nblk, k0 = 64 * kb, n0 = 32 * nb;
#pragma unroll 8
    for (int i = 0; i < 32; ++i) { const int kk = 2 * i + (lane >> 5); scr[kk * 33 + (lane & 31)] = W[(size_t)(k0 + kk) * N + n0 + (lane & 31)]; }
    LDS_WAIT(); asm volatile("" ::: "memory");
    const int c = lane & 7;
#pragma unroll
    for (int j = 0; j < 4; ++j) { const int n = (lane >> 3) + 8 * j; const LAS float* s = scr + (8 * c) * 33 + n;
        v4u o; o.x = pk2(s[0 * 33], s[1 * 33]); o.y = pk2(s[2 * 33], s[3 * 33]); o.z = pk2(s[4 * 33], s[5 * 33]); o.w = pk2(s[6 * 33], s[7 * 33]);
        *(v4u*)(WT + (size_t)(n0 + n) * K + k0 + 8 * c) = o; }
    LDS_WAIT(); asm volatile("" ::: "memory");
}
__device__ __forceinline__ void rms_row_to_bf16(const float* xrow, const float* gain, bf16* orow, int lane) {
    const f32x4* xr = (const f32x4*)xrow + lane; const f32x4* gr = (const f32x4*)gain + lane;
    f32x4 v[16]; float s = 0.f;
#pragma unroll
    for (int j = 0; j < 16; ++j) { v[j] = xr[64 * j]; s += (v[j].x * v[j].x + v[j].y * v[j].y) + (v[j].z * v[j].z + v[j].w * v[j].w); }
    const float rstd = 1.0f / sqrtf(wave_sum(s) * (1.f / DM) + RMS_EPS);
    v2u* o8 = (v2u*)orow + lane;
#pragma unroll
    for (int j = 0; j < 16; ++j) { const f32x4 g = gr[64 * j]; v2u w; w.x = cvt_pk_bf16(v[j].x * rstd * g.x, v[j].y * rstd * g.y); w.y = cvt_pk_bf16(v[j].z * rstd * g.z, v[j].w * rstd * g.w); o8[64 * j] = w; }
}

typedef const f32x4 (&AccRef)[2][2][4][2];
template <int ACT> __device__ __forceinline__ void epi_store_bf16(AccRef acc, bf16* base, int ldc) {
#pragma unroll
    for (int ai = 0; ai < 2; ++ai)
#pragma unroll
        for (int m = 0; m < 4; ++m) { bf16* rowp = base + (size_t)(ai * 128 + m * 16) * ldc;
#pragma unroll
            for (int bj = 0; bj < 2; ++bj) { f32x4 v0 = acc[ai][bj][m][0], v1 = acc[ai][bj][m][1];
                if (ACT == 1) {
#pragma unroll
                    for (int e = 0; e < 4; ++e) { v0[e] = silu_f(v0[e]); v1[e] = silu_f(v1[e]); } }
                v4u w; w.x = cvt_pk_bf16(v0[0], v0[1]); w.y = cvt_pk_bf16(v0[2], v0[3]); w.z = cvt_pk_bf16(v1[0], v1[1]); w.w = cvt_pk_bf16(v1[2], v1[3]);
                *(v4u*)(rowp + bj * 128) = w; } }
}
struct EpiIn {
    bf16 *Q, *Kb, *Vb, *GA, *Ub, *GP; float* out; float* kms;
    __device__ __forceinline__ void operator()(AccRef acc, const pg8::Unit& u, int wr, int wc, int fr, int fq) const {
        const int pn = u.pn, pm = u.pm, row0 = pm * 256 + wr * 64 + fr, cw = wc * 32 + 8 * fq;
        if (pn < 8) { epi_store_bf16<0>(acc, Q + (size_t)row0 * AW + pn * 256 + cw, AW); }
        else if (pn < 12) {
            const int which = (pn - 8) >> 1, cl = ((pn - 8) & 1) * 256 + cw;
            bf16* ob = (which ? Vb : Kb) + (size_t)row0 * KVW + cl;
            epi_store_bf16<0>(acc, ob, KVW);
            float* of = (pm < 32) ? out + (which ? O_VP : O_KP) + (size_t)row0 * KVW + cl : out + (which ? O_VS : O_KS) + (size_t)(row0 - MP) * KVW + cl;
#pragma unroll
            for (int ai = 0; ai < 2; ++ai)
#pragma unroll
                for (int m = 0; m < 4; ++m) { float* rowp = of + (size_t)(ai * 128 + m * 16) * KVW;
#pragma unroll
                    for (int bj = 0; bj < 2; ++bj) { *(f32x4*)(rowp + bj * 128) = acc[ai][bj][m][0]; *(f32x4*)(rowp + bj * 128 + 4) = acc[ai][bj][m][1]; } }
            if (which == 0 && pm < 32) {
#pragma unroll
                for (int bj = 0; bj < 2; ++bj)
#pragma unroll
                    for (int n = 0; n < 2; ++n) { f32x4 s = (f32x4){0.f, 0.f, 0.f, 0.f};
#pragma unroll
                        for (int ai = 0; ai < 2; ++ai)
#pragma unroll
                            for (int m = 0; m < 4; ++m) s += acc[ai][bj][m][n];
#pragma unroll
                        for (int e = 0; e < 4; ++e) { float x = s[e]; x += __shfl_xor(x, 1); x += __shfl_xor(x, 2); x += __shfl_xor(x, 4); x += __shfl_xor(x, 8); s[e] = x; }
                        if (fr == 0) {
#pragma unroll
                            for (int e = 0; e < 4; ++e) __hip_atomic_fetch_add(kms + pm * KVW + cl + bj * 128 + 4 * n + e, s[e], __ATOMIC_RELAXED, __HIP_MEMORY_SCOPE_AGENT); } }
            }
        }
        else if (pn < 20) { epi_store_bf16<1>(acc, GA + (size_t)row0 * AW + (pn - 12) * 256 + cw, AW); }
        else if (pn < 28) {
            const int cl = (pn - 20) * 256 + cw;
            epi_store_bf16<0>(acc, Ub + (size_t)row0 * PW + cl, PW);
            if (pm >= 31) {
#pragma unroll
                for (int ai = 0; ai < 2; ++ai)
#pragma unroll
                    for (int m = 0; m < 4; ++m) { const int r = row0 + ai * 128 + m * 16; float* rowp = nullptr;
                        if (pm == 31) { if (r >= MP - 15) rowp = out + O_PP + (size_t)(r - (MP - 15)) * PW + cl; }
                        else { const int rs = r - MP; rowp = out + O_PS + (size_t)((rs >> 3) * 15 + 7 + (rs & 7)) * PW + cl; }
                        if (rowp) {
#pragma unroll
                            for (int bj = 0; bj < 2; ++bj) { *(f32x4*)(rowp + bj * 128) = acc[ai][bj][m][0]; *(f32x4*)(rowp + bj * 128 + 4) = acc[ai][bj][m][1]; } } }
            }
        }
        else { epi_store_bf16<1>(acc, GP + (size_t)row0 * PW + (pn - 28) * 256 + cw, PW); }
    }
};
struct EpiPool {
    const bf16* GP; const float* scale; bf16* MIX;
    __device__ __forceinline__ void operator()(AccRef acc, const pg8::Unit& u, int wr, int wc, int fr, int fq) const {
        const int row0 = u.pm * 256 + wr * 64 + fr, col0 = u.pn * 256 + wc * 32 + 8 * fq;
        f32x4 sc[2][2];
#pragma unroll
        for (int bj = 0; bj < 2; ++bj) { sc[bj][0] = *(const f32x4*)(scale + col0 + bj * 128); sc[bj][1] = *(const f32x4*)(scale + col0 + bj * 128 + 4); }
#pragma unroll
        for (int ai = 0; ai < 2; ++ai)
#pragma unroll
            for (int m = 0; m < 4; ++m) { const size_t r = (size_t)(row0 + ai * 128 + m * 16);
#pragma unroll
                for (int bj = 0; bj < 2; ++bj) { const v4u g = *(const v4u*)(GP + r * PW + col0 + bj * 128);
                    const f32x4 v0 = acc[ai][bj][m][0] * sc[bj][0], v1 = acc[ai][bj][m][1] * sc[bj][1];
                    v4u w; w.x = cvt_pk_bf16(v0[0] * bflo(g.x), v0[1] * bfhi(g.x)); w.y = cvt_pk_bf16(v0[2] * bflo(g.y), v0[3] * bfhi(g.y));
                    w.z = cvt_pk_bf16(v1[0] * bflo(g.z), v1[1] * bfhi(g.z)); w.w = cvt_pk_bf16(v1[2] * bflo(g.w), v1[3] * bfhi(g.w));
                    *(v4u*)(MIX + r * DM + AW + col0 + bj * 128) = w; } }
    }
};
struct EpiOut {
    const float *x_p, *x_s; float* Y; float* ssq;
    __device__ __forceinline__ void operator()(AccRef acc, const pg8::Unit& u, int wr, int wc, int fr, int fq) const {
        const int row0 = u.pm * 256 + wr * 64 + fr, col0 = u.pn * 256 + wc * 32 + 8 * fq;
        const float* xb = (u.pm < 32) ? x_p + (size_t)row0 * DM : x_s + (size_t)(row0 - MP) * DM;
#pragma unroll
        for (int ai = 0; ai < 2; ++ai)
#pragma unroll
            for (int m = 0; m < 4; ++m) { const size_t ro = (size_t)(ai * 128 + m * 16) * DM + col0; float ss = 0.f;
#pragma unroll
                for (int bj = 0; bj < 2; ++bj) {
                    const f32x4 h0 = acc[ai][bj][m][0] + *(const f32x4*)(xb + ro + bj * 128), h1 = acc[ai][bj][m][1] + *(const f32x4*)(xb + ro + bj * 128 + 4);
                    *(f32x4*)(Y + (size_t)row0 * DM + ro + bj * 128) = h0; *(f32x4*)(Y + (size_t)row0 * DM + ro + bj * 128 + 4) = h1;
                    ss += (h0[0] * h0[0] + h0[1] * h0[1]) + (h0[2] * h0[2] + h0[3] * h0[3]) + (h1[0] * h1[0] + h1[1] * h1[1]) + (h1[2] * h1[2] + h1[3] * h1[3]); }
                ss += __shfl_xor(ss, 16); ss += __shfl_xor(ss, 32);
                if (fq == 0) ssq[(size_t)(row0 + ai * 128 + m * 16) * 64 + u.pn * 4 + wc] = ss; }
    }
};

struct EpiSlab {
    float* slab;
    __device__ __forceinline__ void operator()(AccRef acc, const pg8::Unit& u, int wr, int wc, int fr, int fq) const {
        const int row0 = wr * 64 + fr, col0 = (u.pn & 15) * 256 + wc * 32 + 8 * fq; float* base = slab + ((size_t)(u.pn >> 4) * MS + row0) * DM + col0;
#pragma unroll
        for (int ai = 0; ai < 2; ++ai)
#pragma unroll
            for (int m = 0; m < 4; ++m) { float* rowp = base + (size_t)(ai * 128 + m * 16) * DM;
#pragma unroll
                for (int bj = 0; bj < 2; ++bj) { *(f32x4*)(rowp + bj * 128) = acc[ai][bj][m][0]; *(f32x4*)(rowp + bj * 128 + 4) = acc[ai][bj][m][1]; } }
    }
};

#define KSWZ(row, colB) ((row) * 256 + ((colB) ^ (((row) & 7) << 4)))
#define SBAR() __builtin_amdgcn_sched_barrier(0)
__device__ __forceinline__ int crow(int r, int hi) { return (r & 3) + 8 * (r >> 2) + 4 * hi; }
__device__ __forceinline__ int v_st(int k, int c) { const int kk = (k & ~0xC) | ((k & 4) << 1) | ((k & 8) >> 1); return ((kk >> 3) * 4 + (c >> 5)) * 512 + ((kk & 7) * 32 + (c & 31)) * 2; }
__device__ __forceinline__ int v_rd_base(int lane) { return ((lane & 3) << 3) | (((lane >> 2) & 3) << 6) | (((lane >> 4) & 1) << 5) | (((lane >> 5) & 1) << 8); }
constexpr int v_rd_off(int d0, int ks, int half) { return d0 * 512 + ks * 4096 + half * 2048; }
template <int OFF> __device__ __forceinline__ s16x4 tr_read(int vb) { s16x4 r; asm volatile("ds_read_b64_tr_b16 %0, %1 offset:%2" : "=&v"(r) : "v"(vb), "i"(OFF) : "memory"); return r; }
template <int D0> __device__ __forceinline__ void pv_one(f32x16& od, int vb, bf16x8 pa0, bf16x8 pa1, bf16x8 pa2, bf16x8 pa3) {
    const s16x4 l0 = tr_read<v_rd_off(D0, 0, 0)>(vb), h0 = tr_read<v_rd_off(D0, 0, 1)>(vb), l1 = tr_read<v_rd_off(D0, 1, 0)>(vb), h1 = tr_read<v_rd_off(D0, 1, 1)>(vb);
    const s16x4 l2 = tr_read<v_rd_off(D0, 2, 0)>(vb), h2 = tr_read<v_rd_off(D0, 2, 1)>(vb), l3 = tr_read<v_rd_off(D0, 3, 0)>(vb), h3 = tr_read<v_rd_off(D0, 3, 1)>(vb);
    asm volatile("s_waitcnt lgkmcnt(0)" ::: "memory"); SBAR();
#define PKV(L, H) (bf16x8){L[0], L[1], L[2], L[3], H[0], H[1], H[2], H[3]}
    od = __builtin_amdgcn_mfma_f32_32x32x16_bf16(pa0, PKV(l0, h0), od, 0, 0, 0);
    od = __builtin_amdgcn_mfma_f32_32x32x16_bf16(pa1, PKV(l1, h1), od, 0, 0, 0);
    od = __builtin_amdgcn_mfma_f32_32x32x16_bf16(pa2, PKV(l2, h2), od, 0, 0, 0);
    od = __builtin_amdgcn_mfma_f32_32x32x16_bf16(pa3, PKV(l3, h3), od, 0, 0, 0);
#undef PKV
}
__device__ __forceinline__ void qkt(f32x16& p0, f32x16& p1, const LAS char* Ks, const bf16x8 (&qr)[8], int r32, int hi) {
#pragma unroll
    for (int r = 0; r < 16; ++r) { p0[r] = 0.f; p1[r] = 0.f; }
#pragma unroll
    for (int d0 = 0; d0 < 8; ++d0) { const int cb = (d0 * 16 + hi * 8) * 2;
        const bf16x8 b0 = *(const LAS bf16x8*)(Ks + KSWZ(r32, cb));
        const bf16x8 b1 = *(const LAS bf16x8*)(Ks + KSWZ(32 + r32, cb));
        p0 = __builtin_amdgcn_mfma_f32_32x32x16_bf16(b0, qr[d0], p0, 0, 0, 0);
        p1 = __builtin_amdgcn_mfma_f32_32x32x16_bf16(b1, qr[d0], p1, 0, 0, 0); }
}
__device__ __forceinline__ int rel_bucket_i(int n) {
    if (n < 16) return n;
    const int e = 31 - __clz(n); const unsigned long long n2 = (unsigned long long)n * (unsigned long long)n;
    const int b = 2 * e + (int)((n2 >> (2 * e + 1)) != 0ull) + 8; return b > 31 ? 31 : b;
}
struct KVPrompt { const bf16* K; const bf16* V;
    struct Regs { bf16x8 k0, k1, v0, v1; };
    __device__ __forceinline__ void load(int t, Regs& R, int tid) const {
        const int sr = tid >> 4, sc = (tid & 15) * 8; const size_t o = (size_t)(64 * t + sr) * KVW + sc;
        R.k0 = *(const bf16x8*)(K + o); R.k1 = *(const bf16x8*)(K + o + 32 * KVW); R.v0 = *(const bf16x8*)(V + o); R.v1 = *(const bf16x8*)(V + o + 32 * KVW); }
    __device__ __forceinline__ static void write(const Regs& R, LAS char* Kl, LAS char* Vl, int tid) {
        const int sr = tid >> 4, sc = (tid & 15) * 8;
        *(LAS bf16x8*)(Kl + KSWZ(sr, sc * 2)) = R.k0; *(LAS bf16x8*)(Kl + KSWZ(32 + sr, sc * 2)) = R.k1;
        *(LAS bf16x8*)(Vl + v_st(sr, sc)) = R.v0; *(LAS bf16x8*)(Vl + v_st(32 + sr, sc)) = R.v1; } };
struct KVPaged { const float* ck; const float* cv; const int* pt;
    struct Regs { f32x4 a[8]; };
    __device__ __forceinline__ void load(int t, Regs& R, int tid) const {
        const int sr = tid >> 4, sc = (tid & 15) * 8; const int page = pt[t >> 1];
        const size_t o = ((size_t)page * 128 + 64 * (t & 1) + sr) * KVW + sc;
        R.a[0] = __builtin_nontemporal_load((const f32x4*)(ck + o)); R.a[1] = __builtin_nontemporal_load((const f32x4*)(ck + o + 4));
        R.a[2] = __builtin_nontemporal_load((const f32x4*)(ck + o + 32 * KVW)); R.a[3] = __builtin_nontemporal_load((const f32x4*)(ck + o + 32 * KVW + 4));
        R.a[4] = __builtin_nontemporal_load((const f32x4*)(cv + o)); R.a[5] = __builtin_nontemporal_load((const f32x4*)(cv + o + 4));
        R.a[6] = __builtin_nontemporal_load((const f32x4*)(cv + o + 32 * KVW)); R.a[7] = __builtin_nontemporal_load((const f32x4*)(cv + o + 32 * KVW + 4)); }
    __device__ __forceinline__ static void write(const Regs& R, LAS char* Kl, LAS char* Vl, int tid) {
        const int sr = tid >> 4, sc = (tid & 15) * 8;
        v4u w[4];
#pragma unroll
        for (int i = 0; i < 4; ++i) { w[i].x = cvt_pk_bf16(R.a[2 * i][0], R.a[2 * i][1]); w[i].y = cvt_pk_bf16(R.a[2 * i][2], R.a[2 * i][3]); w[i].z = cvt_pk_bf16(R.a[2 * i + 1][0], R.a[2 * i + 1][1]); w[i].w = cvt_pk_bf16(R.a[2 * i + 1][2], R.a[2 * i + 1][3]); }
        *(LAS v4u*)(Kl + KSWZ(sr, sc * 2)) = w[0]; *(LAS v4u*)(Kl + KSWZ(32 + sr, sc * 2)) = w[1];
        *(LAS v4u*)(Vl + v_st(sr, sc)) = w[2]; *(LAS v4u*)(Vl + v_st(32 + sr, sc)) = w[3]; } };

template <bool CAUSAL>
__device__ __forceinline__ void attn_tile(LAS char* lds, const LAS char* Kl, const LAS char* Vl, const bf16x8 (&qr)[8], int dq, int hl, float& m_reg, float& l_reg, f32x16 (&o)[4], int wid, int lane) {
    const int r32 = lane & 31, hi = lane >> 5;
    LAS float* al_l = (LAS float*)(lds + ATT_WS + wid * 256);
    const LAS float* tab = (const LAS float*)(lds + ATT_TAB) + hl * TABN;
    const int vb = (int)(unsigned)(size_t)Vl + v_rd_base(lane);
    f32x16 p0, p1;
    qkt(p0, p1, Kl, qr, r32, hi);
    const int dqc = dq < 2960 ? dq : 2960;
    const LAS float* tb = tab + (dqc + TAB_NEG - 63 - 4 * hi);
#pragma unroll
    for (int r = 0; r < 16; ++r) { const int k0 = (r & 3) + 8 * (r >> 2);
        p0[r] = fmaf(p0[r], C_SC, tb[63 - k0]); p1[r] = fmaf(p1[r], C_SC, tb[31 - k0]);
        if (CAUSAL) { if (k0 + 4 * hi > dq) p0[r] = -1e30f; if (32 + k0 + 4 * hi > dq) p1[r] = -1e30f; } }
    float pmax = p0[0];
#pragma unroll
    for (int r = 1; r < 16; ++r) pmax = fmaxf(pmax, p0[r]);
#pragma unroll
    for (int r = 0; r < 16; ++r) pmax = fmaxf(pmax, p1[r]);
    { auto rr = __builtin_amdgcn_permlane32_swap(__float_as_uint(pmax), __float_as_uint(pmax), false, false); pmax = fmaxf(__uint_as_float(rr[0]), __uint_as_float(rr[1])); }
    const float mn = fmaxf(m_reg, pmax), alpha = __builtin_amdgcn_exp2f(m_reg - mn); m_reg = mn;
    float ps = 0.f;
#pragma unroll
    for (int r = 0; r < 16; ++r) { p0[r] = __builtin_amdgcn_exp2f(p0[r] - mn); p1[r] = __builtin_amdgcn_exp2f(p1[r] - mn); ps += p0[r] + p1[r]; }
    { auto rr = __builtin_amdgcn_permlane32_swap(__float_as_uint(ps), __float_as_uint(ps), false, false); ps = __uint_as_float(rr[0]) + __uint_as_float(rr[1]); }
    l_reg = l_reg * alpha + ps;
    bf16x8 pa0, pa1, pa2, pa3;
#define PK4(P, BASE, OUT) do { unsigned a0 = cvt_pk_bf16(P[BASE + 0], P[BASE + 1]), a1 = cvt_pk_bf16(P[BASE + 2], P[BASE + 3]); \
        unsigned b0 = cvt_pk_bf16(P[BASE + 4], P[BASE + 5]), b1 = cvt_pk_bf16(P[BASE + 6], P[BASE + 7]); \
        auto r0 = __builtin_amdgcn_permlane32_swap(a0, b0, false, false); auto r1 = __builtin_amdgcn_permlane32_swap(a1, b1, false, false); \
        v4u w = {r0[0], r1[0], r0[1], r1[1]}; OUT = *reinterpret_cast<bf16x8*>(&w); } while (0)
    PK4(p0, 0, pa0); PK4(p0, 8, pa1); PK4(p1, 0, pa2); PK4(p1, 8, pa3);
#undef PK4
    if (__any(alpha < 1.f)) {
        if (hi == 0) al_l[r32] = alpha;
        LDS_WAIT();
#pragma unroll
        for (int r = 0; r < 16; ++r) { const float a = al_l[crow(r, hi)];
#pragma unroll
            for (int d = 0; d < 4; ++d) o[d][r] *= a; }
    }
    pv_one<0>(o[0], vb, pa0, pa1, pa2, pa3); pv_one<1>(o[1], vb, pa0, pa1, pa2, pa3); pv_one<2>(o[2], vb, pa0, pa1, pa2, pa3); pv_one<3>(o[3], vb, pa0, pa1, pa2, pa3);
}
__device__ __forceinline__ void put_inv_l(LAS char* lds, float l_reg, int wid, int lane) {
    LAS float* al_l = (LAS float*)(lds + ATT_WS + wid * 256);
    if ((lane >> 5) == 0) al_l[lane & 31] = 1.0f / l_reg;
    LDS_WAIT();
}
__device__ __forceinline__ void stage_o_half(LAS char* lds, const f32x16 (&o)[4], int hh, int wid, int lane) {
    const int r32 = lane & 31, hi = lane >> 5;
    const LAS float* al_l = (const LAS float*)(lds + ATT_WS + wid * 256);
    LAS bf16* Os = (LAS bf16*)(lds + ATT_OST + wid * 4096);
#pragma unroll
    for (int r = 0; r < 16; ++r) { const int row = crow(r, hi); const float inv = al_l[row];
        Os[row * 64 + r32] = (bf16)f2bf((hh ? o[2][r] : o[0][r]) * inv); Os[row * 64 + 32 + r32] = (bf16)f2bf((hh ? o[3][r] : o[1][r]) * inv); }
    LDS_WAIT();
}
__device__ __forceinline__ void build_bias_table(LAS char* lds, const float* rel_bias, int kvh, int tid) {
    LAS float* rb = (LAS float*)(lds + ATT_RB); LAS float* tab = (LAS float*)(lds + ATT_TAB);
    rb[tid] = rel_bias[tid] * LOG2E;
    __syncthreads();
    for (int e = tid; e < 4 * TABN; e += 512) { const int hl = e / TABN, i = e - hl * TABN; int d = i - TAB_NEG; d = d < 0 ? 0 : d;
        tab[e] = rb[rel_bucket_i(d) * NH + kvh * 4 + hl]; }
}
struct RowInfo { const bf16* qp; int dq0, hl; bool valid, active; size_t oidx; };
struct PolPrompt {
    typedef KVPrompt Src;
    const unsigned* LP; const bf16 *Qb, *Kb, *Vb; bf16* PO; float* PL; const LAS int* pref; const LAS int* cnt; int kvh, gsub, ngsub, nitems;
    __device__ __forceinline__ void locate(int k, int& j, int& tile) const { const int it = gsub + k * ngsub; int jj = 0; while (pref[jj + 1] <= it) ++jj; j = jj; tile = it - pref[jj]; }
    __device__ __forceinline__ Src src(int k) const { int j, tile; locate(k, j, tile); return Src{Kb + (size_t)(256 * j) * KVW + kvh * 128, Vb + (size_t)(256 * j) * KVW + kvh * 128}; }
    __device__ __forceinline__ unsigned entry(int k, int wid, int lane) const { int j, tile; locate(k, j, tile); const int idx = tile * 256 + wid * 32 + (lane & 31);
        return idx < cnt[j] ? LP[(size_t)(kvh * 32 + j) * LP_CAP + idx] : 0x80000000u; }
    __device__ __forceinline__ RowInfo rows(int k, unsigned ent, int wid, int lane) const { int j, tile; locate(k, j, tile);
        const int q = ent & 8191, hl = (ent >> 13) & 3, s = (ent >> 15) & 3; RowInfo r; r.valid = !(ent >> 31); r.hl = hl;
        r.qp = Qb + (size_t)q * AW + (kvh * 4 + hl) * 128 + (lane >> 5) * 8; r.dq0 = r.valid ? q - 256 * j : 4096; r.active = wid * 32 < cnt[j] - tile * 256;
        r.oidx = ((size_t)q * NH + kvh * 4 + hl) * 3 + s; return r; }
};
struct PolSample {
    typedef KVPaged Src;
    const unsigned* LS; const bf16* Qb; const float *ck, *cv; const int* pt; bf16* PO; float* PL; const LAS int* items; const LAS int* cnts; int kvh, nitems;
    __device__ __forceinline__ Src src(int k) const { const int si = items[k], b = si >> 5, j = si & 31; return Src{ck + kvh * 128, cv + kvh * 128, pt + b * 64 + 2 * j}; }
    __device__ __forceinline__ unsigned entry(int k, int wid, int lane) const { const int si = items[k], b = si >> 5, j = si & 31, idx = wid * 32 + (lane & 31);
        return idx < cnts[k] ? LS[((size_t)b * 128 + kvh * 32 + j) * 32 + idx] : 0x80000000u; }
    __device__ __forceinline__ RowInfo rows(int k, unsigned ent, int wid, int lane) const { const int si = items[k], b = si >> 5, j = si & 31;
        const int t = ent & 7, hl = (ent >> 3) & 3, s = (ent >> 5) & 3, row = MP + b * 8 + t; RowInfo r; r.valid = !(ent >> 31); r.hl = hl;
        r.qp = Qb + (size_t)row * AW + (kvh * 4 + hl) * 128 + (lane >> 5) * 8; r.dq0 = r.valid ? MP + t - 256 * j : 4096; r.active = wid * 32 < cnts[k];
        r.oidx = ((size_t)row * NH + kvh * 4 + hl) * 3 + s; return r; }
};
struct PolOwn {
    typedef KVPrompt Src;
    const bf16 *Qb, *Kb, *Vb; int kvh, gsub, ngsub, nitems;
    __device__ __forceinline__ Src src(int k) const { const int b = (gsub + k * ngsub) >> 2; return Src{Kb + (size_t)(256 * b) * KVW + kvh * 128, Vb + (size_t)(256 * b) * KVW + kvh * 128}; }
    __device__ __forceinline__ unsigned entry(int, int, int) const { return 0u; }
    __device__ __forceinline__ RowInfo rows(int k, unsigned, int wid, int lane) const { const int it = gsub + k * ngsub, b = it >> 2, hl = it & 3, ql = wid * 32 + (lane & 31);
        RowInfo r; r.valid = true; r.active = true; r.hl = hl; r.dq0 = ql; r.qp = Qb + (size_t)(256 * b + ql) * AW + (kvh * 4 + hl) * 128 + (lane >> 5) * 8; r.oidx = (size_t)it; return r; }
};
template <bool CAUSAL, class Pol, class Fin>
__device__ __forceinline__ void attn_stream(LAS char* lds, const Pol& pol, const Fin& fin, int tid, int wid, int lane) {
    const int n = pol.nitems;
    if (n <= 0) return;
    typename Pol::Src src = pol.src(0); typename Pol::Src::Regs R;
    src.load(0, R, tid);
    unsigned ent_next = pol.entry(0, wid, lane);
    Pol::Src::write(R, lds + ATT_KV, lds + ATT_KV + 16384, tid);
    __syncthreads();
    for (int k = 0; k < n; ++k) {
        const RowInfo ri = pol.rows(k, ent_next, wid, lane);
        bf16x8 qr[8];
#pragma unroll
        for (int d0 = 0; d0 < 8; ++d0) qr[d0] = *(const bf16x8*)(ri.qp + d0 * 16);
        const bool more_items = (k + 1 < n);
        if (more_items) ent_next = pol.entry(k + 1, wid, lane);
        const typename Pol::Src nsrc = more_items ? pol.src(k + 1) : src;
        float m_reg = -1e30f, l_reg = 0.f; f32x16 o[4];
#pragma unroll
        for (int d = 0; d < 4; ++d)
#pragma unroll
            for (int r = 0; r < 16; ++r) o[d][r] = 0.f;
#pragma unroll
        for (int t = 0; t < 4; ++t) {
            LAS char* Kc = lds + ATT_KV + (t & 1) * 32768; LAS char* Kn = lds + ATT_KV + ((t + 1) & 1) * 32768;
            if (t < 3) src.load(t + 1, R, tid); else if (more_items) nsrc.load(0, R, tid);
            if (ri.active && (!CAUSAL || 64 * t <= 32 * wid + 31)) attn_tile<CAUSAL>(lds, Kc, Kc + 16384, qr, ri.dq0 - 64 * t, ri.hl, m_reg, l_reg, o, wid, lane);
            if (t < 3 || more_items) Pol::Src::write(R, Kn, Kn + 16384, tid);
            __syncthreads();
        }
        fin(k, ri, m_reg, l_reg, o);
        src = nsrc;
    }
}
struct FinPartial { LAS char* lds; bf16* PO; float* PL; int wid, lane;
    __device__ __forceinline__ void operator()(int, const RowInfo& ri, float m_reg, float l_reg, const f32x16 (&o)[4]) const {
        if (!ri.active) return;
        put_inv_l(lds, l_reg, wid, lane);
        if (ri.valid && (lane >> 5) == 0) PL[ri.oidx] = m_reg + __builtin_amdgcn_logf(l_reg);
        const int rr = lane >> 1, q2 = lane & 1;
        const int pv = __shfl((int)ri.valid, rr); const unsigned plo = __shfl((unsigned)ri.oidx, rr);
#pragma unroll
        for (int hh = 0; hh < 2; ++hh) {
            stage_o_half(lds, o, hh, wid, lane);
            if (pv) { const LAS v4u* srow = (const LAS v4u*)(lds + ATT_OST + wid * 4096 + rr * 128 + q2 * 64); v4u* dst = (v4u*)(PO + (size_t)plo * 128 + hh * 64 + q2 * 32);
#pragma unroll
                for (int c = 0; c < 4; ++c) dst[c] = srow[c]; }
            LDS_WAIT();
        }
    }
};
struct FinMerge { LAS char* lds; const bf16* PO; const float* PL; const bf16* GA; bf16* MIX; int kvh, wid, lane;
    __device__ __forceinline__ void operator()(int, const RowInfo& ri, float m_reg, float l_reg, const f32x16 (&o)[4]) const {
        const int it = (int)ri.oidx, b = it >> 2, h = kvh * 4 + (it & 3);
        put_inv_l(lds, l_reg, wid, lane);
        const float lse_own_l = m_reg + __builtin_amdgcn_logf(l_reg);
        const int rr = lane >> 1, q2 = lane & 1, qq = 256 * b + wid * 32 + rr;
        const float lse_own = __shfl(lse_own_l, rr);
        const int nv = b < 3 ? b : 3; const size_t pbase = ((size_t)qq * NH + h) * 3;
        float ls[3], wsl[3]; float M = lse_own;
#pragma unroll
        for (int s = 0; s < 3; ++s) { ls[s] = (s < nv) ? PL[pbase + s] : -1e30f; M = fmaxf(M, ls[s]); }
        const float w_own = __builtin_amdgcn_exp2f(lse_own - M); float W = w_own;
#pragma unroll
        for (int s = 0; s < 3; ++s) { wsl[s] = (s < nv) ? __builtin_amdgcn_exp2f(ls[s] - M) : 0.f; W += wsl[s]; }
        const float invW = 1.0f / W;
#pragma unroll
        for (int hh = 0; hh < 2; ++hh) {
            stage_o_half(lds, o, hh, wid, lane);
            const LAS v4u* srow = (const LAS v4u*)(lds + ATT_OST + wid * 4096 + rr * 128 + q2 * 64);
            const int dcol = h * 128 + hh * 64 + q2 * 32;
            const v4u* ga = (const v4u*)(GA + (size_t)qq * AW + dcol); v4u* dst = (v4u*)(MIX + (size_t)qq * DM + dcol);
#pragma unroll
            for (int c = 0; c < 4; ++c) { const v4u a = srow[c]; float f[8] = {bflo(a.x) * w_own, bfhi(a.x) * w_own, bflo(a.y) * w_own, bfhi(a.y) * w_own, bflo(a.z) * w_own, bfhi(a.z) * w_own, bflo(a.w) * w_own, bfhi(a.w) * w_own};
#pragma unroll
                for (int s = 0; s < 3; ++s) if (s < nv) { const v4u p = *((const v4u*)(PO + (pbase + s) * 128 + hh * 64 + q2 * 32) + c); const float ww = wsl[s];
                    f[0] += ww * bflo(p.x); f[1] += ww * bfhi(p.x); f[2] += ww * bflo(p.y); f[3] += ww * bfhi(p.y); f[4] += ww * bflo(p.z); f[5] += ww * bfhi(p.z); f[6] += ww * bflo(p.w); f[7] += ww * bfhi(p.w); }
                const v4u g = ga[c]; v4u w;
                w.x = cvt_pk_bf16(f[0] * invW * bflo(g.x), f[1] * invW * bfhi(g.x)); w.y = cvt_pk_bf16(f[2] * invW * bflo(g.y), f[3] * invW * bfhi(g.y));
                w.z = cvt_pk_bf16(f[4] * invW * bflo(g.z), f[5] * invW * bfhi(g.z)); w.w = cvt_pk_bf16(f[6] * invW * bflo(g.w), f[7] * invW * bfhi(g.w));
                dst[c] = w; }
            LDS_WAIT();
        }
    }
};
template <int W> __device__ __forceinline__ void pool_task(const bf16* Ub, const float* state_pool, bf16* ZP, int rb, int col) {
    constexpr int NX = 8 + W - 1;
    v4u x[NX];
    const bool smp = rb >= MP / 8; const int r0 = rb * 8, b = rb - MP / 8;
#pragma unroll
    for (int i = 0; i < NX; ++i) { const int off = i - (W - 1);
        if (!smp) { x[i] = (r0 + off >= 0) ? *(const v4u*)(Ub + (size_t)(r0 + off) * PW + col) : (v4u){0u, 0u, 0u, 0u}; }
        else if (off >= 0) x[i] = *(const v4u*)(Ub + (size_t)(r0 + off) * PW + col);
        else { const float* sp = state_pool + (size_t)(b * 15 + 15 + off) * PW + col; const f32x4 a = *(const f32x4*)sp, c = *(const f32x4*)(sp + 4);
            x[i].x = cvt_pk_bf16(a.x, a.y); x[i].y = cvt_pk_bf16(a.z, a.w); x[i].z = cvt_pk_bf16(c.x, c.y); x[i].w = cvt_pk_bf16(c.z, c.w); } }
    float s[8];
#pragma unroll
    for (int e = 0; e < 8; ++e) s[e] = 0.f;
#pragma unroll
    for (int i = 0; i < W - 1; ++i) { s[0] += bflo(x[i].x); s[1] += bfhi(x[i].x); s[2] += bflo(x[i].y); s[3] += bfhi(x[i].y); s[4] += bflo(x[i].z); s[5] += bfhi(x[i].z); s[6] += bflo(x[i].w); s[7] += bfhi(x[i].w); }
#pragma unroll
    for (int k = 0; k < 8; ++k) { const v4u c = x[k + W - 1], old = x[k];
        const float u[8] = {bflo(c.x), bfhi(c.x), bflo(c.y), bfhi(c.y), bflo(c.z), bfhi(c.z), bflo(c.w), bfhi(c.w)};
#pragma unroll
        for (int e = 0; e < 8; ++e) s[e] += u[e];
        const int cnt = smp ? W : ((r0 + k + 1) < W ? (r0 + k + 1) : W); const float inv = 1.0f / (float)cnt;
        v4u ov; ov.x = cvt_pk_bf16(s[0] * inv - u[0], s[1] * inv - u[1]); ov.y = cvt_pk_bf16(s[2] * inv - u[2], s[3] * inv - u[3]);
        ov.z = cvt_pk_bf16(s[4] * inv - u[4], s[5] * inv - u[5]); ov.w = cvt_pk_bf16(s[6] * inv - u[6], s[7] * inv - u[7]);
        *(v4u*)(ZP + (size_t)(r0 + k) * PW + col) = ov;
        s[0] -= bflo(old.x); s[1] -= bfhi(old.x); s[2] -= bflo(old.y); s[3] -= bfhi(old.y); s[4] -= bflo(old.z); s[5] -= bfhi(old.z); s[6] -= bflo(old.w); s[7] -= bfhi(old.w); }
}


__device__ __forceinline__ void cmean_item(const float* cache_k, const int* page_table, float* CMEAN, LAS unsigned char* lds, int it, int tid) {
    LAS f32x4* red = (LAS f32x4*)lds;
    const int c4 = tid & 127, rg = tid >> 7, b = it >> 5, j = it & 31;
    f32x4 acc = (f32x4){0.f, 0.f, 0.f, 0.f};
#pragma unroll
    for (int hpg = 0; hpg < 2; ++hpg) {
        const int page = page_table[b * 64 + 2 * j + hpg];
        const float* base = cache_k + ((size_t)page * 128 + rg) * KVW + c4 * 4;
#pragma unroll 16
        for (int rr = 0; rr < 32; ++rr) acc += __builtin_nontemporal_load((const f32x4*)(base + (size_t)(4 * rr) * KVW));
    }
    red[rg * 128 + c4] = acc;
    __syncthreads();
    if (rg == 0) { const f32x4 s = (red[c4] + red[128 + c4]) + (red[256 + c4] + red[384 + c4]); *(f32x4*)(CMEAN + (size_t)it * KVW + c4 * 4) = s * (1.0f / 256.0f); }
    __syncthreads();
}

__global__ void __launch_bounds__(512, 2) moba_fwd(Params P) {
    extern __shared__ __attribute__((aligned(16))) unsigned char lds_raw[];
    LAS unsigned char* lds = (LAS unsigned char*)lds_raw;
    LAS char* ldc = (LAS char*)lds_raw;
    const int tid = threadIdx.x, lane = tid & 63, wid = __builtin_amdgcn_readfirstlane(tid >> 6);
    const int G = gridDim.x, bid = blockIdx.x;
    unsigned char* ws = P.ws;
    unsigned* ctl = (unsigned*)(ws + WS_CTL);
    bf16* WinT = (bf16*)(ws + WS_WIN); bf16* WoutT = (bf16*)(ws + WS_WOUT); bf16* WpT = (bf16*)(ws + WS_WP); bf16* XN = (bf16*)(ws + WS_XN);
    bf16* Qb = (bf16*)(ws + WS_Q); bf16* GA = (bf16*)(ws + WS_GA); bf16* Ub = (bf16*)(ws + WS_U); bf16* GP = (bf16*)(ws + WS_GP); bf16* ZP = (bf16*)(ws + WS_ZP);
    bf16* Kb = (bf16*)(ws + WS_K); bf16* Vb = (bf16*)(ws + WS_V); bf16* MIX = (bf16*)(ws + WS_MIX);
    float* CMEAN = (float*)(ws + WS_CMEAN); unsigned* LP = (unsigned*)(ws + WS_LP); unsigned* LS = (unsigned*)(ws + WS_LS);
    bf16* PO = (bf16*)(ws + WS_PO); float* PL = (float*)(ws + WS_PL); float* SSQ = (float*)(ws + WS_SSQ); float* SLAB = (float*)(ws + WS_SLAB);
    float* KMS = (float*)(ctl + CW_KMS); unsigned* cntP = ctl + CW_CNTP; unsigned* cntS = ctl + CW_CNTS;

    for (int u = tid; u < (LDS_BYTES - LDSCTL_OFF) / 4; u += 512) ((LAS unsigned*)(lds + LDSCTL_OFF))[u] = 0u;
    __syncthreads();
    volatile LAS unsigned* MISC = (volatile LAS unsigned*)(lds + LDSCTL_OFF + 320);
    const int lo = P.ph_lo, hi_ph = P.ph_hi;
    XcdBarrier bar; bar.bar = ctl + CW_BAR; bar.x = 0; bar.st = nullptr;
    if (MK_N_LAUNCHES == 1) bar = xcd_barrier_post(ctl + CW_BAR + P.li * XCD_BAR_WORDS, MISC + 8);
#define IN(k) (lo <= (k) && (k) < hi_ph)
#define SEAM(k) do { if (MK_N_LAUNCHES == 1 && IN(k) && IN((k) + 1)) xcd_barrier(bar); } while (0)

    if (IN(0)) {
        LAS float* scr = (LAS float*)(lds + wid * 16384);
        const int gw = bid * 8 + wid, NGW = G * 8;
        constexpr int I_IN = (DM / 64) * (NIN / 32), I_OUT = (DM / 64) * (DM / 32), I_PG = (512 / 64) * (512 / 32);
        for (int it = gw; it < I_IN + I_OUT + 4 * I_PG; it += NGW) {
            int r = it;
            if (r < I_IN) { p0_transpose_item(P.w_in, DM, NIN, WinT, scr, r, lane); continue; } r -= I_IN;
            if (r < I_OUT) { p0_transpose_item(P.w_out, DM, DM, WoutT, scr, r, lane); continue; } r -= I_OUT;
            const int g = r / I_PG; p0_transpose_item(P.w_pool + (size_t)g * 512 * 512, 512, 512, WpT + (size_t)g * 512 * 512, scr, r - g * I_PG, lane);
        }
        for (int m = gw; m < MT; m += NGW) rms_row_to_bf16(m < MP ? P.x_p + (size_t)m * DM : P.x_s + (size_t)(m - MP) * DM, P.norm_in, XN + (size_t)m * DM, lane);
        __syncthreads();
        for (int it = bid; it < CM_SPLIT; it += G) cmean_item(P.cache_k, P.page_table, CMEAN, lds, it, tid);
    }
    SEAM(0);

    if (IN(1)) {
        pg8::Gemm g{XN, WinT, MT, NIN, DM, DM, DM, 0, 0, 0x7fffffff, 0}; pg8::StaticOrder S; S.init(MT, NIN, G, bid);
        EpiIn E{Qb, Kb, Vb, GA, Ub, GP, P.out, KMS};
        pg8::gemm_phase<EpiIn>(lds, g, S, E);
        const int nunits = (MT / 256) * (NIN / 256), nshort = G - (nunits % G);
        if (nunits % G != 0 && bid >= nunits % G) { for (int it = CM_SPLIT + (bid - nunits % G); it < 1024; it += nshort) cmean_item(P.cache_k, P.page_table, CMEAN, lds, it, tid); }
        else if (nunits % G == 0) { for (int it = CM_SPLIT + bid; it < 1024; it += G) cmean_item(P.cache_k, P.page_table, CMEAN, lds, it, tid); }
    }
    SEAM(1);

    if (IN(2)) {
        LAS float* KM = (LAS float*)lds;
        LAS int* cntL = (LAS int*)(lds + 65536); LAS int* baseL = cntL + 128; LAS int* SELL = baseL + 128; LAS int* LPL = SELL + 32 * 48;
        const int h = lane >> 2, part = lane & 3, kvh = h >> 2;
        for (int ch = bid; ch < 256 + 32; ch += G) {
            const bool smp = ch >= 256; const int b_s = ch - 256;
            const int nblk = smp ? 32 : (ch >> 3);
            const int nvalid = nblk < 3 ? nblk : 3;
            __syncthreads();
            if (smp) { for (int e = tid; e < 32 * 128; e += 512) ((LAS f32x4*)KM)[e] = *(const f32x4*)(CMEAN + (size_t)b_s * 32 * KVW + e * 4); }
            else { for (int e = tid; e < nblk * 128; e += 512) ((LAS f32x4*)KM)[e] = *(const f32x4*)(KMS + e * 4) * (1.0f / 256.0f); }
            if (tid < 128) cntL[tid] = 0;
            __syncthreads();
            const int nrow = smp ? 1 : 4;
            for (int i = 0; i < nrow; ++i) {
                const int rl = smp ? wid : wid * 4 + i;
                const int r = smp ? MP + b_s * 8 + wid : ch * 32 + rl;
                float q[32];
                { const v4u* qp = (const v4u*)(Qb + (size_t)r * AW + h * 128 + part * 32);
#pragma unroll
                  for (int c = 0; c < 4; ++c) { const v4u w = qp[c]; q[8 * c + 0] = bflo(w.x); q[8 * c + 1] = bfhi(w.x); q[8 * c + 2] = bflo(w.y); q[8 * c + 3] = bfhi(w.y);
                      q[8 * c + 4] = bflo(w.z); q[8 * c + 5] = bfhi(w.z); q[8 * c + 6] = bflo(w.w); q[8 * c + 7] = bfhi(w.w); } }
                float v0 = -3.0e38f, v1 = -3.0e38f, v2 = -3.0e38f; int i0 = 0, i1 = 0, i2 = 0;
                for (int n = 0; n < nblk; ++n) {
                    const LAS f32x4* km = (const LAS f32x4*)(KM + n * KVW + kvh * 128 + part * 32);
                    float a = 0.f;
#pragma unroll
                    for (int c = 0; c < 8; ++c) { const f32x4 k4 = km[c]; a = fmaf(q[4 * c], k4.x, a); a = fmaf(q[4 * c + 1], k4.y, a); a = fmaf(q[4 * c + 2], k4.z, a); a = fmaf(q[4 * c + 3], k4.w, a); }
                    a += __shfl_xor(a, 1); a += __shfl_xor(a, 2);
                    if (a > v0) { v2 = v1; i2 = i1; v1 = v0; i1 = i0; v0 = a; i0 = n; }
                    else if (a > v1) { v2 = v1; i2 = i1; v1 = a; i1 = n; }
                    else if (a > v2) { v2 = a; i2 = n; }
                }
                if (part == 0) {
                    const int e0 = (rl * 16 + h) * 3;
                    if (nvalid > 0) { SELL[e0] = i0; LPL[e0] = __hip_atomic_fetch_add(&cntL[kvh * 32 + i0], 1, __ATOMIC_RELAXED, __HIP_MEMORY_SCOPE_WORKGROUP); }
                    if (nvalid > 1) { SELL[e0 + 1] = i1; LPL[e0 + 1] = __hip_atomic_fetch_add(&cntL[kvh * 32 + i1], 1, __ATOMIC_RELAXED, __HIP_MEMORY_SCOPE_WORKGROUP); }
                    if (nvalid > 2) { SELL[e0 + 2] = i2; LPL[e0 + 2] = __hip_atomic_fetch_add(&cntL[kvh * 32 + i2], 1, __ATOMIC_RELAXED, __HIP_MEMORY_SCOPE_WORKGROUP); }
                }
            }
            __syncthreads();
            if (tid < 128) { const int c = cntL[tid];
                if (smp) { baseL[tid] = 0; cntS[b_s * 128 + tid] = (unsigned)c; }
                else baseL[tid] = c ? (int)__hip_atomic_fetch_add(cntP + tid, (unsigned)c, __ATOMIC_RELAXED, __HIP_MEMORY_SCOPE_AGENT) : 0; }
            __syncthreads();
            const int nent = (smp ? 8 : 32) * 48;
            for (int e = tid; e < nent; e += 512) { const int s = e % 3; if (s >= nvalid) continue;
                const int hh = (e / 3) & 15, rl = e / 48, j = SELL[e], lp = LPL[e], li = (hh >> 2) * 32 + j;
                if (smp) LS[((size_t)b_s * 128 + li) * 32 + lp] = (unsigned)(rl | ((hh & 3) << 3) | (s << 5));
                else LP[(size_t)li * LP_CAP + baseL[li] + lp] = (unsigned)((ch * 32 + rl) | ((hh & 3) << 13) | (s << 15)); }
        }
        for (int task = bid * 512 + tid; task < (MT / 8) * 256; task += G * 512) {
            const int rb = task >> 8, col = (task & 255) * 8;
            switch (col >> 9) { case 0: pool_task<2>(Ub, P.state_pool, ZP, rb, col); break; case 1: pool_task<4>(Ub, P.state_pool, ZP, rb, col); break;
                                case 2: pool_task<8>(Ub, P.state_pool, ZP, rb, col); break; default: pool_task<16>(Ub, P.state_pool, ZP, rb, col); break; }
        }
        for (int e = bid * 512 + tid; e < 32 * 7 * (PW / 4); e += G * 512) { const int c4 = e % (PW / 4), rr = (e / (PW / 4)) % 7, b = e / (7 * (PW / 4));
            *(f32x4*)(P.out + O_PS + (size_t)(b * 15 + rr) * PW + c4 * 4) = *(const f32x4*)(P.state_pool + (size_t)(b * 15 + 8 + rr) * PW + c4 * 4); }
    }
    SEAM(2);

    if (IN(3)) {
        {
            pg8::Gemm g{ZP, WpT, MT, PW, 512, PW, 512, 1, 512, 0x7fffffff, 0}; pg8::StaticOrder S; S.init(MT, PW, G, bid);
            EpiPool E{GP, P.pool_scale, MIX};
            pg8::gemm_phase<EpiPool>(lds, g, S, E);
        }
        const int kvh = bid & 3, gsub = bid >> 2, ngsub = G >> 2;
        __syncthreads();
        build_bias_table(ldc, P.rel_bias, kvh, tid);
        LAS int* pref = (LAS int*)(lds + ATT_MISC); LAS int* cntl = pref + 40; LAS int* sitems = cntl + 32; LAS int* scnts = sitems + 24; LAS int* nsi = scnts + 24;
        if (tid == 0) { int a = 0; for (int j = 0; j < 32; ++j) { const int c = (int)cntP[kvh * 32 + j]; cntl[j] = c; pref[j] = a; a += (c + 255) >> 8; } pref[32] = a;
            int ns = 0; for (int si = gsub; si < 1024; si += ngsub) { const int c = (int)cntS[(si >> 5) * 128 + kvh * 32 + (si & 31)]; if (c > 0) { sitems[ns] = si; scnts[ns] = c; ++ns; } } *nsi = ns; }
        __syncthreads();
        {
            const int npi = pref[32];
            PolPrompt pol{LP, Qb, Kb, Vb, PO, PL, pref, cntl, kvh, gsub, ngsub, npi > gsub ? (npi - gsub + ngsub - 1) / ngsub : 0};
            FinPartial fin{ldc, PO, PL, wid, lane};
            attn_stream<false, PolPrompt, FinPartial>(ldc, pol, fin, tid, wid, lane);
        }
        {
            PolSample pol{LS, Qb, P.cache_k, P.cache_v, P.page_table, PO, PL, sitems, scnts, kvh, *nsi};
            FinPartial fin{ldc, PO, PL, wid, lane};
            attn_stream<false, PolSample, FinPartial>(ldc, pol, fin, tid, wid, lane);
        }
    }
    SEAM(3);

    if (IN(4)) {
        const int kvh = bid & 3, gsub = bid >> 2, ngsub = G >> 2;
        __syncthreads();
        build_bias_table(ldc, P.rel_bias, kvh, tid);
        __syncthreads();
        {
            PolOwn pol{Qb, Kb, Vb, kvh, gsub, ngsub, 128 > gsub ? (128 - gsub + ngsub - 1) / ngsub : 0};
            FinMerge fin{ldc, PO, PL, GA, MIX, kvh, wid, lane};
            attn_stream<true, PolOwn, FinMerge>(ldc, pol, fin, tid, wid, lane);
        }
        for (int task = bid * 8 + wid; task < MS * NH; task += G * 8) {
            const int h = task & 15, rs = task >> 4, b = rs >> 3, t = rs & 7, row = MP + rs, kv = h >> 2;
            const unsigned qw = *(const unsigned*)(Qb + (size_t)row * AW + h * 128 + 2 * lane); const float q0 = bflo(qw), q1 = bfhi(qw);
            float x[8], vx[8], vy[8]; const size_t pbase = ((size_t)row * NH + h) * 3;
            float M = fmaxf(fmaxf(PL[pbase], PL[pbase + 1]), PL[pbase + 2]);
#pragma unroll
            for (int tp = 0; tp < 8; ++tp) { x[tp] = -1e30f; vx[tp] = 0.f; vy[tp] = 0.f;
                if (tp <= t) { const size_t ko = (size_t)(MP + b * 8 + tp) * KVW + kv * 128 + 2 * lane; const unsigned kw = *(const unsigned*)(Kb + ko), vw = *(const unsigned*)(Vb + ko);
                    x[tp] = wave_sum(q0 * bflo(kw) + q1 * bfhi(kw)) * C_SC + P.rel_bias[(t - tp) * NH + h] * LOG2E; vx[tp] = bflo(vw); vy[tp] = bfhi(vw); M = fmaxf(M, x[tp]); } }
            float W = 0.f, a0 = 0.f, a1 = 0.f;
#pragma unroll
            for (int tp = 0; tp < 8; ++tp) { const float w = (tp <= t) ? __builtin_amdgcn_exp2f(x[tp] - M) : 0.f; W += w; a0 += w * vx[tp]; a1 += w * vy[tp]; }
#pragma unroll
            for (int s = 0; s < 3; ++s) { const float w = __builtin_amdgcn_exp2f(PL[pbase + s] - M); const unsigned pw = *(const unsigned*)(PO + (pbase + s) * 128 + 2 * lane); W += w; a0 += w * bflo(pw); a1 += w * bfhi(pw); }
            const unsigned gw = *(const unsigned*)(GA + (size_t)row * AW + h * 128 + 2 * lane); const float inv = 1.0f / W;
            *(unsigned*)(MIX + (size_t)row * DM + h * 128 + 2 * lane) = cvt_pk_bf16(a0 * inv * bflo(gw), a1 * inv * bfhi(gw));
        }
    }
    SEAM(4);

    if (IN(5)) {
        {
            pg8::Gemm g{MIX, WoutT, MP, DM, DM, DM, DM, 0, 0, 0x7fffffff, 0}; pg8::StaticOrder S; S.init(MP, DM, G, bid);
            EpiOut E{P.x_p, P.x_s, P.out + O_Y, SSQ};
            pg8::gemm_phase<EpiOut>(lds, g, S, E);
        }
        {
            pg8::Gemm g{MIX + (size_t)MP * DM, WoutT, MS, 128 * 256, 512, DM, DM, 4, 512, 15, 512}; pg8::StaticOrder S; S.init(MS, 128 * 256, G, bid);
            EpiSlab E{SLAB};
            pg8::gemm_phase<EpiSlab>(lds, g, S, E);
        }
    }
    SEAM(5);

    if (IN(6)) {
        const int gw = bid * 8 + wid, NGW = G * 8;
        if (gw < MS) {
            const int m = gw; f32x4 v[16]; float ss = 0.f;
            const f32x4* xr = (const f32x4*)(P.x_s + (size_t)m * DM) + lane;
#pragma unroll
            for (int j = 0; j < 16; ++j) v[j] = xr[64 * j];
#pragma unroll
            for (int ks = 0; ks < 8; ++ks) { const f32x4* sr = (const f32x4*)(SLAB + ((size_t)ks * MS + m) * DM) + lane;
#pragma unroll
                for (int j = 0; j < 16; ++j) v[j] += sr[64 * j]; }
#pragma unroll
            for (int j = 0; j < 16; ++j) ss += (v[j].x * v[j].x + v[j].y * v[j].y) + (v[j].z * v[j].z + v[j].w * v[j].w);
            const float rstd = 1.0f / sqrtf(wave_sum(ss) * (1.f / DM) + RMS_EPS);
            f32x4* y = (f32x4*)(P.out + O_Y + (size_t)(MP + m) * DM) + lane; const f32x4* gn = (const f32x4*)P.norm_out + lane;
#pragma unroll
            for (int j = 0; j < 16; ++j) { const f32x4 g = gn[64 * j]; f32x4 o = v[j]; o.x *= rstd * g.x; o.y *= rstd * g.y; o.z *= rstd * g.z; o.w *= rstd * g.w; y[64 * j] = o; }
        }
        for (int m = NGW - 1 - gw; m < MP; m += NGW) {
            const float ss = wave_sum(SSQ[(size_t)m * 64 + lane]);
            const float rstd = 1.0f / sqrtf(ss * (1.f / DM) + RMS_EPS);
            f32x4* y = (f32x4*)(P.out + O_Y + (size_t)m * DM) + lane; const f32x4* gn = (const f32x4*)P.norm_out + lane;
#pragma unroll
            for (int j = 0; j < 16; ++j) { const f32x4 g = gn[64 * j]; f32x4 v = y[64 * j]; v.x *= rstd * g.x; v.y *= rstd * g.y; v.z *= rstd * g.z; v.w *= rstd * g.w; y[64 * j] = v; }
        }
    }
#undef IN
#undef SEAM
}

extern "C" void kernel_launch(void* const* d_in, const int* in_sizes, int n_in, void* d_out, int out_size, void* d_ws, size_t ws_size, hipStream_t stream) {
    static int grid = 0;
    if (grid == 0) {
        if (n_in != 13 || (size_t)out_size != O_END || ws_size < WS_END) { fprintf(stderr, "kernel_launch: unexpected shapes (n_in %d out %d ws %zu)\n", n_in, out_size, ws_size); grid = -1; return; }
        int dev = 0, cus = 0, per_cu = 0;
        if (hipGetDevice(&dev) != hipSuccess || hipDeviceGetAttribute(&cus, hipDeviceAttributeMultiprocessorCount, dev) != hipSuccess) { grid = -1; return; }
        if (hipFuncSetAttribute((const void*)moba_fwd, hipFuncAttributeMaxDynamicSharedMemorySize, LDS_BYTES) != hipSuccess) { fprintf(stderr, "kernel_launch: hipFuncSetAttribute failed\n"); grid = -1; return; }
        if (hipOccupancyMaxActiveBlocksPerMultiprocessor(&per_cu, (const void*)moba_fwd, 512, LDS_BYTES) != hipSuccess || per_cu < 1) fprintf(stderr, "kernel_launch: occupancy query reports %d\n", per_cu);
        (void)hipGetLastError();
        grid = cus;
        if (grid % 4 != 0) { fprintf(stderr, "kernel_launch: grid %d not a multiple of 4\n", grid); grid = -1; return; }
    }
    if (grid < 0) return;
    (void)hipMemsetAsync((char*)d_ws + WS_CTL, 0, CTL_ZERO_BYTES, stream);
    Params p{};
    p.x_p = (const float*)d_in[0]; p.x_s = (const float*)d_in[1]; p.cache_k = (const float*)d_in[2]; p.cache_v = (const float*)d_in[3]; p.state_pool = (const float*)d_in[4];
    p.page_table = (const int*)d_in[5]; p.norm_in = (const float*)d_in[6]; p.w_in = (const float*)d_in[7]; p.w_pool = (const float*)d_in[8]; p.pool_scale = (const float*)d_in[9];
    p.w_out = (const float*)d_in[10]; p.rel_bias = (const float*)d_in[11]; p.norm_out = (const float*)d_in[12];
    p.out = (float*)d_out; p.ws = (unsigned char*)d_ws;
#if MK_N_LAUNCHES == 1 && PROBE_REP >= 0
    p.ph_lo = 0; p.ph_hi = (PROBE_REP == 5 || PROBE_REP == 6) ? 7 : PROBE_REP + 1; p.li = 0;
    hipLaunchKernelGGL(moba_fwd, dim3(grid), dim3(512), LDS_BYTES, stream, p);
#if PROBE_REP == 1
    (void)hipMemsetAsync((char*)d_ws + WS_CTL + CW_KMS * 4, 0, 32 * 512 * 4, stream);
#elif PROBE_REP == 2
    (void)hipMemsetAsync((char*)d_ws + WS_CTL + CW_CNTP * 4, 0, (CW_KMS - CW_CNTP) * 4, stream);
#endif
    p.ph_lo = PROBE_REP; p.ph_hi = 7; p.li = 1;
    hipLaunchKernelGGL(moba_fwd, dim3(grid), dim3(512), LDS_BYTES, stream, p);
#elif MK_N_LAUNCHES == 1
    p.ph_lo = 0; p.ph_hi = 7;
    hipLaunchKernelGGL(moba_fwd, dim3(grid), dim3(512), LDS_BYTES, stream, p);
#else
    for (int ph = 0; ph < 7; ++ph) { p.ph_lo = ph; p.ph_hi = ph + 1; hipLaunchKernelGGL(moba_fwd, dim3(grid), dim3(512), LDS_BYTES, stream, p); }
#endif
}
```

```cpp
#include <hip/hip_runtime.h>
#include <cstdio>
#include <cstdint>

#ifndef MK_N_LAUNCHES
#define MK_N_LAUNCHES 1
#endif

#ifndef PROBE_REP
#define PROBE_REP -1
#endif
#define GAS __attribute__((address_space(1)))
#define LAS __attribute__((address_space(3)))
typedef unsigned short bf16;
typedef unsigned v4u __attribute__((ext_vector_type(4)));
typedef unsigned v2u __attribute__((ext_vector_type(2)));
typedef float f32x4 __attribute__((ext_vector_type(4)));
typedef float f32x2 __attribute__((ext_vector_type(2)));
typedef float f32x16 __attribute__((ext_vector_type(16)));
typedef short bf16x8 __attribute__((ext_vector_type(8)));
typedef short s16x4 __attribute__((ext_vector_type(4)));

constexpr int MP = 8192, MS = 256, MT = MP + MS, DM = 4096, NIN = 9216, AW = 2048, KVW = 512, PW = 2048, NH = 16;
constexpr float LOG2E = 1.4426950408889634f;
constexpr float C_SC = 0.08838834764831845f * LOG2E;
constexpr float RMS_EPS = 1e-6f;
constexpr size_t O_Y = 0, O_KP = (size_t)MT * DM, O_VP = O_KP + (size_t)MP * KVW, O_PP = O_VP + (size_t)MP * KVW, O_KS = O_PP + 15 * PW, O_VS = O_KS + (size_t)MS * KVW,
                 O_PS = O_VS + (size_t)MS * KVW, O_END = O_PS + (size_t)32 * 15 * PW;
constexpr size_t MiB = 1u << 20;
constexpr size_t WS_CTL = 0, CTL_ZERO_BYTES = 1 * MiB;
constexpr size_t WS_WIN = 1 * MiB, WS_WOUT = 73 * MiB, WS_WP = 105 * MiB, WS_XN = 107 * MiB, WS_Q = 173 * MiB, WS_GA = 206 * MiB, WS_U = 239 * MiB, WS_GP = 272 * MiB, WS_ZP = 305 * MiB,
                 WS_K = 338 * MiB, WS_V = 347 * MiB, WS_MIX = 356 * MiB, WS_CMEAN = 422 * MiB, WS_LP = 424 * MiB, WS_LS = 440 * MiB, WS_PO = 441 * MiB, WS_PL = 540 * MiB, WS_SSQ = 542 * MiB,
                 WS_SLAB = 545 * MiB  , WS_END = 577 * MiB;
constexpr int CW_TMO = 0, CW_BAR = 256, CW_CNTP = 8192, CW_CNTS = 8448, CW_KMS = 16384;
constexpr int LP_CAP = 32768;
constexpr int CM_SPLIT = 192;
constexpr int RING_BYTES = 131072, LDSCTL_OFF = 152576, LDS_BYTES = 153600;
constexpr int ATT_KV = 0, ATT_TAB = 65536, TABN = 3104, TAB_NEG = 128, ATT_WS = ATT_TAB + 4 * TABN * 4  , ATT_RB = ATT_WS + 2048  , ATT_MISC = ATT_RB + 2048  , ATT_OST = 119808;
static_assert(ATT_MISC + 512 <= ATT_OST && ATT_OST + 32768 <= LDSCTL_OFF && LDSCTL_OFF + 1024 <= LDS_BYTES, "attention LDS map");

#define LDS_WAIT() asm volatile("s_waitcnt lgkmcnt(0)" ::: "memory")
#define VM_WAIT() asm volatile("s_waitcnt vmcnt(0)" ::: "memory")
__device__ __forceinline__ unsigned cvt_pk_bf16(float lo, float hi) { unsigned r; asm volatile("v_cvt_pk_bf16_f32 %0, %1, %2" : "=v"(r) : "v"(lo), "v"(hi)); return r; }
__device__ __forceinline__ float bf2f(unsigned short b) { return __uint_as_float(((unsigned)b) << 16); }
__device__ __forceinline__ float bflo(unsigned w) { return __uint_as_float(w << 16); }
__device__ __forceinline__ float bfhi(unsigned w) { return __uint_as_float(w & 0xffff0000u); }
__device__ __forceinline__ float silu_f(float x) { return x * __builtin_amdgcn_rcpf(1.0f + __builtin_amdgcn_exp2f(-x * LOG2E)); }
__device__ __forceinline__ float wave_sum(float v) {
#pragma unroll
    for (int o = 1; o < 64; o <<= 1) v += __shfl_xor(v, o);
    return v;
}

namespace pg8 {
#define PG8_LAS __attribute__((address_space(3)))
typedef unsigned short bf16_t;
constexpr int BM = 256, BK = 64, HALF = 128, HTB = HALF * BK * 2, STAGE_BYTES = 8 * HTB, NXCD = 8, WGM = 8;
__host__ __device__ __forceinline__ int lds_byte(int r, int c) { const int st = (r >> 4) * 2 + (c >> 5), rr = r & 15, cc = c & 31, ob = rr * 64 + cc * 2; return st * 1024 + (ob ^ (((ob >> 9) & 1) << 5)); }
__host__ __device__ __forceinline__ void stage_rc(int b, int& R, int& C) { const int st = b / 1024, sb = b % 1024, swz = sb ^ (((sb >> 9) & 1) << 5); R = (st >> 1) * 16 + swz / 64; C = (st & 1) * 32 + (swz % 64) / 2; }
__host__ __device__ __forceinline__ int perm32(int rho) { const int n = rho >> 4, i = rho & 15; return 8 * (i >> 2) + 4 * n + (i & 3); }
struct Unit { int pm, pn; };
struct Gemm { const bf16_t* A; const bf16_t* Bt; int M, N, K, lda, ldb, grp_shift, grp_acol, b_mask, grp_bcol; };
struct StaticOrder {
    int nM, nN, nwg, G, c;
    __device__ void init(int M, int N, int G_, int c_) { nM = M / BM; nN = N / BM; nwg = nM * nN; G = G_; c = c_; }
    __device__ bool next(int i, Unit& u) const {
        const long L = (long)i * G + c; if (L >= nwg) return false;
        int wgid = (int)L; { const int q = nwg / NXCD, r = nwg % NXCD, xcd = wgid % NXCD, off = wgid / NXCD; wgid = (xcd < r ? xcd * (q + 1) : r * (q + 1) + (xcd - r) * q) + off; }
        const int nig = WGM * nN, gid = wgid / nig, fm = gid * WGM, gsz = (nM - fm) < WGM ? (nM - fm) : WGM;
        u.pm = fm + ((wgid % nig) % gsz); u.pn = (wgid % nig) / gsz; return true;
    }
};
template <class Epi>
__device__ __forceinline__ void gemm_phase(PG8_LAS unsigned char* lds, const Gemm g, const StaticOrder& S, const Epi& E) {
    const int tid = threadIdx.x, wid = __builtin_amdgcn_readfirstlane(tid >> 6), lane = tid & 63, wr = wid >> 2, wc = wid & 3, fr = lane & 15, fq = lane >> 4;
    const int K = g.K, nt = K / BK;
    unsigned voffA[2], voffB[2];
#pragma unroll
    for (int i = 0; i < 2; ++i) { int R, C; stage_rc(tid * 16 + i * 8192, R, C); const int Rb = (R & ~31) + perm32(R & 31);
        voffA[i] = (unsigned)(R * g.lda + C) * 2u; voffB[i] = (unsigned)(Rb * g.ldb + C) * 2u; }
    const size_t kstep = (size_t)(BK * 2);
    const size_t hstepA = (size_t)HALF * g.lda * 2, hstepB = (size_t)HALF * g.ldb * 2;
    const size_t tstepA = 2 * hstepA, tstepB = 2 * hstepB;
    const unsigned ldsw = (unsigned)wid * 1024u;
    const int aoff = lds_byte(wr * 64 + fr, fq * 8), boff = lds_byte(wc * 32 + fr, fq * 8);
#define PG8_SA(b, h) (((b) * 2 + (h)) * HTB)
#define PG8_SB(b, h) ((4 + (b) * 2 + (h)) * HTB)
#define PG8_STAGE(bufoff, gbase, voff) do { _Pragma("unroll") for (int _i = 0; _i < 2; ++_i) \
        __builtin_amdgcn_global_load_lds((const unsigned*)((const char*)(gbase) + (voff)[_i]), (PG8_LAS unsigned*)(lds + (bufoff) + ldsw + _i * 8192), 16, 0, 0); } while (0)
#define PG8_LDA(dst, b, h) do { _Pragma("unroll") for (int m = 0; m < 4; ++m) _Pragma("unroll") for (int k = 0; k < 2; ++k) dst[m][k] = *(const PG8_LAS bf16x8*)(lds + PG8_SA(b, h) + aoff + m * 2048 + k * 1024); } while (0)
#define PG8_LDB(dst, b, h) do { _Pragma("unroll") for (int n = 0; n < 2; ++n) _Pragma("unroll") for (int k = 0; k < 2; ++k) dst[n][k] = *(const PG8_LAS bf16x8*)(lds + PG8_SB(b, h) + boff + n * 2048 + k * 1024); } while (0)
#define PG8_MMA(ai, bj, At, Bt) do { __builtin_amdgcn_s_setprio(1); _Pragma("unroll") for (int m = 0; m < 4; ++m) _Pragma("unroll") for (int n = 0; n < 2; ++n) _Pragma("unroll") for (int k = 0; k < 2; ++k) \
        acc[ai][bj][m][n] = __builtin_amdgcn_mfma_f32_16x16x32_bf16(Bt[n][k], At[m][k], acc[ai][bj][m][n], 0, 0, 0); __builtin_amdgcn_s_setprio(0); } while (0)
#define PG8_WAIT_V(n) asm volatile("s_waitcnt vmcnt(" #n ")" ::: "memory")
#define PG8_WAIT_L(n) asm volatile("s_waitcnt lgkmcnt(" #n ")" ::: "memory")
#define PG8_BAR __builtin_amdgcn_s_barrier()
#define PG8_SCHED __builtin_amdgcn_sched_barrier(0)
#define PG8_APTR(u) ((const char*)g.A + (size_t)(u).pm * tstepA + (size_t)(((u).pn >> g.grp_shift) * g.grp_acol) * 2)
#define PG8_BPTR(u) ((const char*)g.Bt + (size_t)((u).pn & g.b_mask) * tstepB + (size_t)(((u).pn >> g.grp_shift) * g.grp_bcol) * 2)
    Unit cur, nxt; int ui = 0;
    if (!S.next(0, cur)) return;
    f32x4 acc[2][2][4][2];
#pragma unroll
    for (int a = 0; a < 2; ++a)
#pragma unroll
        for (int b = 0; b < 2; ++b)
#pragma unroll
            for (int m = 0; m < 4; ++m)
#pragma unroll
                for (int n = 0; n < 2; ++n) acc[a][b][m][n] = (f32x4){0.f, 0.f, 0.f, 0.f};
    bf16x8 At[4][2], B0[2][2], B1[2][2];
    const char* cA = PG8_APTR(cur); const char* cB = PG8_BPTR(cur);
    PG8_STAGE(PG8_SB(0, 0), cB, voffB); PG8_STAGE(PG8_SB(0, 1), cB + hstepB, voffB); PG8_STAGE(PG8_SA(0, 0), cA, voffA); PG8_STAGE(PG8_SA(0, 1), cA + hstepA, voffA);
    if (wr == 1) PG8_BAR;
    PG8_WAIT_V(2); PG8_BAR;
    PG8_STAGE(PG8_SB(1, 0), cB + kstep, voffB); PG8_STAGE(PG8_SA(1, 0), cA + kstep, voffA); PG8_STAGE(PG8_SB(1, 1), cB + hstepB + kstep, voffB);
    PG8_WAIT_V(6); PG8_BAR;
    for (;;) {
        const bool has_next = S.next(ui + 1, nxt);
        const char* nA = has_next ? PG8_APTR(nxt) : cA; const char* nB = has_next ? PG8_BPTR(nxt) : cB;
        for (int t = 0; t < nt; t += 2) {
            const bool last = (t == nt - 2);
            const char* a1 = cA + (size_t)(t + 1) * kstep;
            const char* a2 = last ? nA : cA + (size_t)(t + 2) * kstep; const char* b2 = last ? nB : cB + (size_t)(t + 2) * kstep;
            const char* a3 = a2 + kstep; const char* b3 = b2 + kstep;
            PG8_LDB(B0, 0, 0); PG8_LDB(B1, 0, 1); PG8_SCHED; PG8_LDA(At, 0, 0); PG8_STAGE(PG8_SA(1, 1), a1 + hstepA, voffA);
            PG8_WAIT_V(8); PG8_WAIT_L(0); PG8_BAR; PG8_MMA(0, 0, At, B0); PG8_MMA(0, 1, At, B1); PG8_BAR; PG8_SCHED;
            PG8_LDA(At, 0, 1); PG8_STAGE(PG8_SB(0, 0), b2, voffB); PG8_STAGE(PG8_SB(0, 1), b2 + hstepB, voffB); PG8_STAGE(PG8_SA(0, 0), a2, voffA);
            PG8_WAIT_V(8); PG8_WAIT_L(0); PG8_BAR; PG8_MMA(1, 0, At, B0); PG8_MMA(1, 1, At, B1); PG8_BAR; PG8_SCHED;
            PG8_LDB(B0, 1, 0); PG8_LDB(B1, 1, 1); PG8_SCHED; PG8_LDA(At, 1, 0); PG8_STAGE(PG8_SA(0, 1), a2 + hstepA, voffA);
            PG8_WAIT_V(8); PG8_WAIT_L(0); PG8_BAR; PG8_MMA(0, 0, At, B0); PG8_MMA(0, 1, At, B1); PG8_BAR; PG8_SCHED;
            PG8_LDA(At, 1, 1); PG8_STAGE(PG8_SB(1, 0), b3, voffB); PG8_STAGE(PG8_SB(1, 1), b3 + hstepB, voffB); PG8_STAGE(PG8_SA(1, 0), a3, voffA);
            PG8_WAIT_V(8); PG8_WAIT_L(0); PG8_BAR; PG8_MMA(1, 0, At, B0); PG8_MMA(1, 1, At, B1); PG8_BAR; PG8_SCHED;
        }
        if (wr == 0) PG8_BAR;
        E(acc, cur, wr, wc, fr, fq);
        if (!has_next) break;
#pragma unroll
        for (int a = 0; a < 2; ++a)
#pragma unroll
            for (int b = 0; b < 2; ++b)
#pragma unroll
                for (int m = 0; m < 4; ++m)
#pragma unroll
                    for (int n = 0; n < 2; ++n) acc[a][b][m][n] = (f32x4){0.f, 0.f, 0.f, 0.f};
        cur = nxt; cA = nA; cB = nB; ++ui;
        if (wr == 1) PG8_BAR;
    }
    PG8_WAIT_V(0);
    PG8_BAR;
#undef PG8_SA
#undef PG8_SB
#undef PG8_STAGE
#undef PG8_LDA
#undef PG8_LDB
#undef PG8_MMA
#undef PG8_WAIT_V
#undef PG8_WAIT_L
#undef PG8_BAR
#undef PG8_SCHED
#undef PG8_APTR
#undef PG8_BPTR
}
}

#define XB_TMO      128
#define XB_XCNT(j)  (256  + 64 * (j))
#define XB_XSUB(j)  (1280 + 64 * (j))
#define XB_XGEN(j)  (2304 + 64 * (j))
#define XB_TOP      3328
#define XB_TOPGEN   3392
#define XCD_BAR_WORDS 3456
#define XB_SPIN_CAP (1u << 18)
__device__ __forceinline__ unsigned xb_ld(unsigned* p)              { return __hip_atomic_load(p, __ATOMIC_RELAXED, __HIP_MEMORY_SCOPE_AGENT); }
__device__ __forceinline__ unsigned xb_add(unsigned* p, unsigned v) { return __hip_atomic_fetch_add(p, v, __ATOMIC_RELAXED, __HIP_MEMORY_SCOPE_AGENT); }
__device__ __forceinline__ unsigned xb_xcc_id() { return (unsigned)__builtin_amdgcn_s_getreg((3 << 11) | 20) & 0xFu; }
#define XB_SPIN(cond, bar) do { unsigned _sp = 0; while (cond) { __builtin_amdgcn_s_sleep(1); \
    if ((++_sp & 255u) == 0u) { if (xb_ld(&(bar)[XB_TMO])) break; if (_sp > XB_SPIN_CAP) { atomicAdd(&(bar)[XB_TMO], 1u); break; } } } } while (0)
struct XcdBarrier { unsigned* bar; unsigned x; volatile LAS unsigned* st; };
__device__ __forceinline__ XcdBarrier xcd_barrier_post(unsigned* bar, volatile LAS unsigned* st) {
    XcdBarrier b; b.bar = bar; b.x = xb_xcc_id(); b.st = st;
    if (threadIdx.x == 0) (void)xb_add(&bar[XB_XCNT(b.x)], 1u);
    return b;
}
__device__ __forceinline__ void xcd_barrier_complete(unsigned* bar, unsigned x, unsigned& nloc, unsigned& nx) {
    const unsigned G = gridDim.x * gridDim.y * gridDim.z;
    unsigned sum, cnt, mine, sp = 0u;
    for (;;) {
        sum = 0u; cnt = 0u; mine = 0u;
#pragma unroll
        for (unsigned j = 0; j < 16; ++j) { const unsigned c = xb_ld(&bar[XB_XCNT(j)]); sum += c; cnt += (c > 0u) ? 1u : 0u; mine = (j == x) ? c : mine; }
        if (sum == G) break;
        __builtin_amdgcn_s_sleep(1);
        if ((++sp & 255u) == 0u) { if (xb_ld(&bar[XB_TMO])) break; if (sp > XB_SPIN_CAP) { atomicAdd(&bar[XB_TMO], 1u); break; } }
    }
    nloc = mine > 0u ? mine : 1u; nx = cnt > 0u ? cnt : 1u;
}
__device__ __forceinline__ void xcd_barrier(const XcdBarrier& b) {
    asm volatile("s_waitcnt vmcnt(0)" ::: "memory");
    __syncthreads();
    if (threadIdx.x == 0) {
        unsigned* bar = b.bar;
        __builtin_amdgcn_s_waitcnt(0);
        unsigned nloc = b.st[0], nx = b.st[1];
        if (nloc == 0u) { xcd_barrier_complete(bar, b.x, nloc, nx); b.st[0] = nloc; b.st[1] = nx; }
        const unsigned old = xb_add(&bar[XB_XSUB(b.x)], 1u);
        const unsigned gen = old / nloc;
        if (old + 1u == (gen + 1u) * nloc) {
            __builtin_amdgcn_fence(__ATOMIC_RELEASE, "agent");
            asm volatile("s_waitcnt vmcnt(0)" ::: "memory");
            const unsigned og = xb_add(&bar[XB_TOP], 1u);
            const unsigned tg = og / nx;
            if (og + 1u == (tg + 1u) * nx) xb_add(&bar[XB_TOPGEN], 1u);
            else XB_SPIN(xb_ld(&bar[XB_TOPGEN]) == tg, bar);
            __builtin_amdgcn_fence(__ATOMIC_ACQUIRE, "agent");
            xb_add(&bar[XB_XGEN(b.x)], 1u);
            asm volatile("s_waitcnt vmcnt(0)" ::: "memory");
        } else {
            XB_SPIN(xb_ld(&bar[XB_XGEN(b.x)]) == gen, bar);
            __builtin_amdgcn_fence(__ATOMIC_ACQUIRE, "agent");
            asm volatile("s_waitcnt vmcnt(0)" ::: "memory");
        }
    }
    __syncthreads();
}

struct Params {
    const float *x_p, *x_s, *cache_k, *cache_v, *state_pool; const int* page_table;
    const float *norm_in, *w_in, *w_pool, *pool_scale, *w_out, *rel_bias, *norm_out;
    float* out; unsigned char* ws; int ph_lo, ph_hi, li, pad;
};

__device__ __forceinline__ unsigned f2bf(float f) { unsigned u = __builtin_bit_cast(unsigned, f); return (u + 0x7fffu + ((u >> 16) & 1u)) >> 16; }
__device__ __forceinline__ unsigned pk2(float lo, float hi) { return f2bf(lo) | (f2bf(hi) << 16); }
__device__ __forceinline__ void p0_transpose_item(const float* W, int K, int N, bf16* WT, LAS float* scr, int item, int lane) {
    const int nblk = N / 32, kb = item / nblk, nb = item % nblk, k0 = 64 * kb, n0 = 32 * nb;
#pragma unroll 8
    for (int i = 0; i < 32; ++i) { const int kk = 2 * i + (lane >> 5); scr[kk * 33 + (lane & 31)] = W[(size_t)(k0 + kk) * N + n0 + (lane & 31)]; }
    LDS_WAIT(); asm volatile("" ::: "memory");
    const int c = lane & 7;
#pragma unroll
    for (int j = 0; j < 4; ++j) { const int n = (lane >> 3) + 8 * j; const LAS float* s = scr + (8 * c) * 33 + n;
        v4u o; o.x = pk2(s[0 * 33], s[1 * 33]); o.y = pk2(s[2 * 33], s[3 * 33]); o.z = pk2(s[4 * 33], s[5 * 33]); o.w = pk2(s[6 * 33], s[7 * 33]);
        *(v4u*)(WT + (size_t)(n0 + n) * K + k0 + 8 * c) = o; }
    LDS_WAIT(); asm volatile("" ::: "memory");
}
__device__ __forceinline__ void rms_row_to_bf16(const float* xrow, const float* gain, bf16* orow, int lane) {
    const f32x4* xr = (const f32x4*)xrow + lane; const f32x4* gr = (const f32x4*)gain + lane;
    f32x4 v[16]; float s = 0.f;
#pragma unroll
    for (int j = 0; j < 16; ++j) { v[j] = xr[64 * j]; s += (v[j].x * v[j].x + v[j].y * v[j].y) + (v[j].z * v[j].z + v[j].w * v[j].w); }
    const float rstd = 1.0f / sqrtf(wave_sum(s) * (1.f / DM) + RMS_EPS);
    v2u* o8 = (v2u*)orow + lane;
#pragma unroll
    for (int j = 0; j < 16; ++j) { const f32x4 g = gr[64 * j]; v2u w; w.x = cvt_pk_bf16(v[j].x * rstd * g.x, v[j].y * rstd * g.y); w.y = cvt_pk_bf16(v[j].z * rstd * g.z, v[j].w * rstd * g.w); o8[64 * j] = w; }
}

typedef const f32x4 (&AccRef)[2][2][4][2];
template <int ACT> __device__ __forceinline__ void epi_store_bf16(AccRef acc, bf16* base, int ldc) {
#pragma unroll
    for (int ai = 0; ai < 2; ++ai)
#pragma unroll
        for (int m = 0; m < 4; ++m) { bf16* rowp = base + (size_t)(ai * 128 + m * 16) * ldc;
#pragma unroll
            for (int bj = 0; bj < 2; ++bj) { f32x4 v0 = acc[ai][bj][m][0], v1 = acc[ai][bj][m][1];
                if (ACT == 1) {
#pragma unroll
                    for (int e = 0; e < 4; ++e) { v0[e] = silu_f(v0[e]); v1[e] = silu_f(v1[e]); } }
                v4u w; w.x = cvt_pk_bf16(v0[0], v0[1]); w.y = cvt_pk_bf16(v0[2], v0[3]); w.z = cvt_pk_bf16(v1[0], v1[1]); w.w = cvt_pk_bf16(v1[2], v1[3]);
                *(v4u*)(rowp + bj * 128) = w; } }
}
struct EpiIn {
    bf16 *Q, *Kb, *Vb, *GA, *Ub, *GP; float* out; float* kms;
    __device__ __forceinline__ void operator()(AccRef acc, const pg8::Unit& u, int wr, int wc, int fr, int fq) const {
        const int pn = u.pn, pm = u.pm, row0 = pm * 256 + wr * 64 + fr, cw = wc * 32 + 8 * fq;
        if (pn < 8) { epi_store_bf16<0>(acc, Q + (size_t)row0 * AW + pn * 256 + cw, AW); }
        else if (pn < 12) {
            const int which = (pn - 8) >> 1, cl = ((pn - 8) & 1) * 256 + cw;
            bf16* ob = (which ? Vb : Kb) + (size_t)row0 * KVW + cl;
            epi_store_bf16<0>(acc, ob, KVW);
            float* of = (pm < 32) ? out + (which ? O_VP : O_KP) + (size_t)row0 * KVW + cl : out + (which ? O_VS : O_KS) + (size_t)(row0 - MP) * KVW + cl;
#pragma unroll
            for (int ai = 0; ai < 2; ++ai)
#pragma unroll
                for (int m = 0; m < 4; ++m) { float* rowp = of + (size_t)(ai * 128 + m * 16) * KVW;
#pragma unroll
                    for (int bj = 0; bj < 2; ++bj) { *(f32x4*)(rowp + bj * 128) = acc[ai][bj][m][0]; *(f32x4*)(rowp + bj * 128 + 4) = acc[ai][bj][m][1]; } }
            if (which == 0 && pm < 32) {
#pragma unroll
                for (int bj = 0; bj < 2; ++bj)
#pragma unroll
                    for (int n = 0; n < 2; ++n) { f32x4 s = (f32x4){0.f, 0.f, 0.f, 0.f};
#pragma unroll
                        for (int ai = 0; ai < 2; ++ai)
#pragma unroll
                            for (int m = 0; m < 4; ++m) s += acc[ai][bj][m][n];
#pragma unroll
                        for (int e = 0; e < 4; ++e) { float x = s[e]; x += __shfl_xor(x, 1); x += __shfl_xor(x, 2); x += __shfl_xor(x, 4); x += __shfl_xor(x, 8); s[e] = x; }
                        if (fr == 0) {
#pragma unroll
                            for (int e = 0; e < 4; ++e) __hip_atomic_fetch_add(kms + pm * KVW + cl + bj * 128 + 4 * n + e, s[e], __ATOMIC_RELAXED, __HIP_MEMORY_SCOPE_AGENT); } }
            }
        }
        else if (pn < 20) { epi_store_bf16<1>(acc, GA + (size_t)row0 * AW + (pn - 12) * 256 + cw, AW); }
        else if (pn < 28) {
            const int cl = (pn - 20) * 256 + cw;
            epi_store_bf16<0>(acc, Ub + (size_t)row0 * PW + cl, PW);
            if (pm >= 31) {
#pragma unroll
                for (int ai = 0; ai < 2; ++ai)
#pragma unroll
                    for (int m = 0; m < 4; ++m) { const int r = row0 + ai * 128 + m * 16; float* rowp = nullptr;
                        if (pm == 31) { if (r >= MP - 15) rowp = out + O_PP + (size_t)(r - (MP - 15)) * PW + cl; }
                        else { const int rs = r - MP; rowp = out + O_PS + (size_t)((rs >> 3) * 15 + 7 + (rs & 7)) * PW + cl; }
                        if (rowp) {
#pragma unroll
                            for (int bj = 0; bj < 2; ++bj) { *(f32x4*)(rowp + bj * 128) = acc[ai][bj][m][0]; *(f32x4*)(rowp + bj * 128 + 4) = acc[ai][bj][m][1]; } } }
            }
        }
        else { epi_store_bf16<1>(acc, GP + (size_t)row0 * PW + (pn - 28) * 256 + cw, PW); }
    }
};
struct EpiPool {
    const bf16* GP; const float* scale; bf16* MIX;
    __device__ __forceinline__ void operator()(AccRef acc, const pg8::Unit& u, int wr, int wc, int fr, int fq) const {
        const int row0 = u.pm * 256 + wr * 64 + fr, col0 = u.pn * 256 + wc * 32 + 8 * fq;
        f32x4 sc[2][2];
#pragma unroll
        for (int bj = 0; bj < 2; ++bj) { sc[bj][0] = *(const f32x4*)(scale + col0 + bj * 128); sc[bj][1] = *(const f32x4*)(scale + col0 + bj * 128 + 4); }
#pragma unroll
        for (int ai = 0; ai < 2; ++ai) {
            v4u gv[4][2];
#pragma unroll
            for (int m = 0; m < 4; ++m)
#pragma unroll
                for (int bj = 0; bj < 2; ++bj) gv[m][bj] = *(const v4u*)(GP + (size_t)(row0 + ai * 128 + m * 16) * PW + col0 + bj * 128);
#pragma unroll
            for (int m = 0; m < 4; ++m) { const size_t r = (size_t)(row0 + ai * 128 + m * 16);
#pragma unroll
                for (int bj = 0; bj < 2; ++bj) { const v4u g = gv[m][bj];
                    const f32x4 v0 = acc[ai][bj][m][0] * sc[bj][0], v1 = acc[ai][bj][m][1] * sc[bj][1];
                    v4u w; w.x = cvt_pk_bf16(v0[0] * bflo(g.x), v0[1] * bfhi(g.x)); w.y = cvt_pk_bf16(v0[2] * bflo(g.y), v0[3] * bfhi(g.y));
                    w.z = cvt_pk_bf16(v1[0] * bflo(g.z), v1[1] * bfhi(g.z)); w.w = cvt_pk_bf16(v1[2] * bflo(g.w), v1[3] * bfhi(g.w));
                    *(v4u*)(MIX + r * DM + AW + col0 + bj * 128) = w; } }
        }
    }
};
struct EpiOut {
    const float *x_p, *x_s; float* Y; float* ssq;
    __device__ __forceinline__ void operator()(AccRef acc, const pg8::Unit& u, int wr, int wc, int fr, int fq) const {
        const int row0 = u.pm * 256 + wr * 64 + fr, col0 = u.pn * 256 + wc * 32 + 8 * fq;
        const float* xb = (u.pm < 32) ? x_p + (size_t)row0 * DM : x_s + (size_t)(row0 - MP) * DM;
#pragma unroll
        for (int ai = 0; ai < 2; ++ai) {
            f32x4 xv[4][2][2];
#pragma unroll
            for (int m = 0; m < 4; ++m)
#pragma unroll
                for (int bj = 0; bj < 2; ++bj) { const float* xp = xb + (size_t)(ai * 128 + m * 16) * DM + col0 + bj * 128; xv[m][bj][0] = *(const f32x4*)xp; xv[m][bj][1] = *(const f32x4*)(xp + 4); }
#pragma unroll
            for (int m = 0; m < 4; ++m) { const size_t ro = (size_t)(ai * 128 + m * 16) * DM + col0; float ss = 0.f;
#pragma unroll
                for (int bj = 0; bj < 2; ++bj) {
                    const f32x4 h0 = acc[ai][bj][m][0] + xv[m][bj][0], h1 = acc[ai][bj][m][1] + xv[m][bj][1];
                    *(f32x4*)(Y + (size_t)row0 * DM + ro + bj * 128) = h0; *(f32x4*)(Y + (size_t)row0 * DM + ro + bj * 128 + 4) = h1;
                    ss += (h0[0] * h0[0] + h0[1] * h0[1]) + (h0[2] * h0[2] + h0[3] * h0[3]) + (h1[0] * h1[0] + h1[1] * h1[1]) + (h1[2] * h1[2] + h1[3] * h1[3]); }
                ss += __shfl_xor(ss, 16); ss += __shfl_xor(ss, 32);
                if (fq == 0) ssq[(size_t)(row0 + ai * 128 + m * 16) * 64 + u.pn * 4 + wc] = ss; }
        }
    }
};
struct EpiSlab {
    float* slab;
    __device__ __forceinline__ void operator()(AccRef acc, const pg8::Unit& u, int wr, int wc, int fr, int fq) const {
        const int row0 = wr * 64 + fr, col0 = (u.pn & 15) * 256 + wc * 32 + 8 * fq; float* base = slab + ((size_t)(u.pn >> 4) * MS + row0) * DM + col0;
#pragma unroll
        for (int ai = 0; ai < 2; ++ai)
#pragma unroll
            for (int m = 0; m < 4; ++m) { float* rowp = base + (size_t)(ai * 128 + m * 16) * DM;
#pragma unroll
                for (int bj = 0; bj < 2; ++bj) { *(f32x4*)(rowp + bj * 128) = acc[ai][bj][m][0]; *(f32x4*)(rowp + bj * 128 + 4) = acc[ai][bj][m][1]; } }
    }
};

#define KSWZ(row, colB) ((row) * 256 + ((colB) ^ (((row) & 7) << 4)))
#define SBAR() __builtin_amdgcn_sched_barrier(0)
__device__ __forceinline__ int crow(int r, int hi) { return (r & 3) + 8 * (r >> 2) + 4 * hi; }
__device__ __forceinline__ int v_st(int k, int c) { const int kk = (k & ~0xC) | ((k & 4) << 1) | ((k & 8) >> 1); return ((kk >> 3) * 4 + (c >> 5)) * 512 + ((kk & 7) * 32 + (c & 31)) * 2; }
__device__ __forceinline__ int v_rd_base(int lane) { return ((lane & 3) << 3) | (((lane >> 2) & 3) << 6) | (((lane >> 4) & 1) << 5) | (((lane >> 5) & 1) << 8); }
constexpr int v_rd_off(int d0, int ks, int half) { return d0 * 512 + ks * 4096 + half * 2048; }
template <int OFF> __device__ __forceinline__ s16x4 tr_read(int vb) { s16x4 r; asm volatile("ds_read_b64_tr_b16 %0, %1 offset:%2" : "=&v"(r) : "v"(vb), "i"(OFF) : "memory"); return r; }
template <int D0> __device__ __forceinline__ void pv_one(f32x16& od, int vb, bf16x8 pa0, bf16x8 pa1, bf16x8 pa2, bf16x8 pa3) {
    const s16x4 l0 = tr_read<v_rd_off(D0, 0, 0)>(vb), h0 = tr_read<v_rd_off(D0, 0, 1)>(vb), l1 = tr_read<v_rd_off(D0, 1, 0)>(vb), h1 = tr_read<v_rd_off(D0, 1, 1)>(vb);
    const s16x4 l2 = tr_read<v_rd_off(D0, 2, 0)>(vb), h2 = tr_read<v_rd_off(D0, 2, 1)>(vb), l3 = tr_read<v_rd_off(D0, 3, 0)>(vb), h3 = tr_read<v_rd_off(D0, 3, 1)>(vb);
    asm volatile("s_waitcnt lgkmcnt(0)" ::: "memory"); SBAR();
#define PKV(L, H) (bf16x8){L[0], L[1], L[2], L[3], H[0], H[1], H[2], H[3]}
    od = __builtin_amdgcn_mfma_f32_32x32x16_bf16(pa0, PKV(l0, h0), od, 0, 0, 0);
    od = __builtin_amdgcn_mfma_f32_32x32x16_bf16(pa1, PKV(l1, h1), od, 0, 0, 0);
    od = __builtin_amdgcn_mfma_f32_32x32x16_bf16(pa2, PKV(l2, h2), od, 0, 0, 0);
    od = __builtin_amdgcn_mfma_f32_32x32x16_bf16(pa3, PKV(l3, h3), od, 0, 0, 0);
#undef PKV
}
__device__ __forceinline__ void qkt(f32x16& p0, f32x16& p1, const LAS char* Ks, const bf16x8 (&qr)[8], int r32, int hi) {
#pragma unroll
    for (int r = 0; r < 16; ++r) { p0[r] = 0.f; p1[r] = 0.f; }
#pragma unroll
    for (int d0 = 0; d0 < 8; ++d0) { const int cb = (d0 * 16 + hi * 8) * 2;
        const bf16x8 b0 = *(const LAS bf16x8*)(Ks + KSWZ(r32, cb));
        const bf16x8 b1 = *(const LAS bf16x8*)(Ks + KSWZ(32 + r32, cb));
        p0 = __builtin_amdgcn_mfma_f32_32x32x16_bf16(b0, qr[d0], p0, 0, 0, 0);
        p1 = __builtin_amdgcn_mfma_f32_32x32x16_bf16(b1, qr[d0], p1, 0, 0, 0); }
}
__device__ __forceinline__ int rel_bucket_i(int n) {
    if (n < 16) return n;
    const int e = 31 - __clz(n); const unsigned long long n2 = (unsigned long long)n * (unsigned long long)n;
    const int b = 2 * e + (int)((n2 >> (2 * e + 1)) != 0ull) + 8; return b > 31 ? 31 : b;
}
struct KVPrompt { const bf16* K; const bf16* V;
    struct Regs { bf16x8 k0, k1, v0, v1; };
    __device__ __forceinline__ void load(int t, Regs& R, int tid) const {
        const int sr = tid >> 4, sc = (tid & 15) * 8; const size_t o = (size_t)(64 * t + sr) * KVW + sc;
        R.k0 = *(const bf16x8*)(K + o); R.k1 = *(const bf16x8*)(K + o + 32 * KVW); R.v0 = *(const bf16x8*)(V + o); R.v1 = *(const bf16x8*)(V + o + 32 * KVW); }
    __device__ __forceinline__ static void write(const Regs& R, LAS char* Kl, LAS char* Vl, int tid) {
        const int sr = tid >> 4, sc = (tid & 15) * 8;
        *(LAS bf16x8*)(Kl + KSWZ(sr, sc * 2)) = R.k0; *(LAS bf16x8*)(Kl + KSWZ(32 + sr, sc * 2)) = R.k1;
        *(LAS bf16x8*)(Vl + v_st(sr, sc)) = R.v0; *(LAS bf16x8*)(Vl + v_st(32 + sr, sc)) = R.v1; } };
struct KVPaged { const float* ck; const float* cv; const int* pt;
    struct Regs { f32x4 a[8]; };
    __device__ __forceinline__ void load(int t, Regs& R, int tid) const {
        const int sr = tid >> 4, sc = (tid & 15) * 8; const int page = pt[t >> 1];
        const size_t o = ((size_t)page * 128 + 64 * (t & 1) + sr) * KVW + sc;
        R.a[0] = __builtin_nontemporal_load((const f32x4*)(ck + o)); R.a[1] = __builtin_nontemporal_load((const f32x4*)(ck + o + 4));
        R.a[2] = __builtin_nontemporal_load((const f32x4*)(ck + o + 32 * KVW)); R.a[3] = __builtin_nontemporal_load((const f32x4*)(ck + o + 32 * KVW + 4));
        R.a[4] = __builtin_nontemporal_load((const f32x4*)(cv + o)); R.a[5] = __builtin_nontemporal_load((const f32x4*)(cv + o + 4));
        R.a[6] = __builtin_nontemporal_load((const f32x4*)(cv + o + 32 * KVW)); R.a[7] = __builtin_nontemporal_load((const f32x4*)(cv + o + 32 * KVW + 4)); }
    __device__ __forceinline__ static void write(const Regs& R, LAS char* Kl, LAS char* Vl, int tid) {
        const int sr = tid >> 4, sc = (tid & 15) * 8;
        v4u w[4];
#pragma unroll
        for (int i = 0; i < 4; ++i) { w[i].x = cvt_pk_bf16(R.a[2 * i][0], R.a[2 * i][1]); w[i].y = cvt_pk_bf16(R.a[2 * i][2], R.a[2 * i][3]); w[i].z = cvt_pk_bf16(R.a[2 * i + 1][0], R.a[2 * i + 1][1]); w[i].w = cvt_pk_bf16(R.a[2 * i + 1][2], R.a[2 * i + 1][3]); }
        *(LAS v4u*)(Kl + KSWZ(sr, sc * 2)) = w[0]; *(LAS v4u*)(Kl + KSWZ(32 + sr, sc * 2)) = w[1];
        *(LAS v4u*)(Vl + v_st(sr, sc)) = w[2]; *(LAS v4u*)(Vl + v_st(32 + sr, sc)) = w[3]; } };

template <bool CAUSAL>
__device__ __forceinline__ void attn_tile(LAS char* lds, const LAS char* Kl, const LAS char* Vl, const bf16x8 (&qr)[8], int dq, int hl, float& m_reg, float& l_reg, f32x16 (&o)[4], int wid, int lane) {
    const int r32 = lane & 31, hi = lane >> 5;
    LAS float* al_l = (LAS float*)(lds + ATT_WS + wid * 256);
    const LAS float* tab = (const LAS float*)(lds + ATT_TAB) + hl * TABN;
    const int vb = (int)(unsigned)(size_t)Vl + v_rd_base(lane);
    f32x16 p0, p1;
    qkt(p0, p1, Kl, qr, r32, hi);
    const int dqc = dq < 2960 ? dq : 2960;
    const LAS float* tb = tab + (dqc + TAB_NEG - 63 - 4 * hi);
#pragma unroll
    for (int r = 0; r < 16; ++r) { const int k0 = (r & 3) + 8 * (r >> 2);
        p0[r] = fmaf(p0[r], C_SC, tb[63 - k0]); p1[r] = fmaf(p1[r], C_SC, tb[31 - k0]);
        if (CAUSAL) { if (k0 + 4 * hi > dq) p0[r] = -1e30f; if (32 + k0 + 4 * hi > dq) p1[r] = -1e30f; } }
    float pmax = p0[0];
#pragma unroll
    for (int r = 1; r < 16; ++r) pmax = fmaxf(pmax, p0[r]);
#pragma unroll
    for (int r = 0; r < 16; ++r) pmax = fmaxf(pmax, p1[r]);
    { auto rr = __builtin_amdgcn_permlane32_swap(__float_as_uint(pmax), __float_as_uint(pmax), false, false); pmax = fmaxf(__uint_as_float(rr[0]), __uint_as_float(rr[1])); }
    const float mn = fmaxf(m_reg, pmax), alpha = __builtin_amdgcn_exp2f(m_reg - mn); m_reg = mn;
    float ps = 0.f;
#pragma unroll
    for (int r = 0; r < 16; ++r) { p0[r] = __builtin_amdgcn_exp2f(p0[r] - mn); p1[r] = __builtin_amdgcn_exp2f(p1[r] - mn); ps += p0[r] + p1[r]; }
    { auto rr = __builtin_amdgcn_permlane32_swap(__float_as_uint(ps), __float_as_uint(ps), false, false); ps = __uint_as_float(rr[0]) + __uint_as_float(rr[1]); }
    l_reg = l_reg * alpha + ps;
    bf16x8 pa0, pa1, pa2, pa3;
#define PK4(P, BASE, OUT) do { unsigned a0 = cvt_pk_bf16(P[BASE + 0], P[BASE + 1]), a1 = cvt_pk_bf16(P[BASE + 2], P[BASE + 3]); \
        unsigned b0 = cvt_pk_bf16(P[BASE + 4], P[BASE + 5]), b1 = cvt_pk_bf16(P[BASE + 6], P[BASE + 7]); \
        auto r0 = __builtin_amdgcn_permlane32_swap(a0, b0, false, false); auto r1 = __builtin_amdgcn_permlane32_swap(a1, b1, false, false); \
        v4u w = {r0[0], r1[0], r0[1], r1[1]}; OUT = *reinterpret_cast<bf16x8*>(&w); } while (0)
    PK4(p0, 0, pa0); PK4(p0, 8, pa1); PK4(p1, 0, pa2); PK4(p1, 8, pa3);
#undef PK4
    if (__any(alpha < 1.f)) {
        if (hi == 0) al_l[r32] = alpha;
        LDS_WAIT();
#pragma unroll
        for (int r = 0; r < 16; ++r) { const float a = al_l[crow(r, hi)];
#pragma unroll
            for (int d = 0; d < 4; ++d) o[d][r] *= a; }
    }
    pv_one<0>(o[0], vb, pa0, pa1, pa2, pa3); pv_one<1>(o[1], vb, pa0, pa1, pa2, pa3); pv_one<2>(o[2], vb, pa0, pa1, pa2, pa3); pv_one<3>(o[3], vb, pa0, pa1, pa2, pa3);
}
__device__ __forceinline__ void put_inv_l(LAS char* lds, float l_reg, int wid, int lane) {
    LAS float* al_l = (LAS float*)(lds + ATT_WS + wid * 256);
    if ((lane >> 5) == 0) al_l[lane & 31] = 1.0f / l_reg;
    LDS_WAIT();
}
__device__ __forceinline__ void stage_o_half(LAS char* lds, const f32x16 (&o)[4], int hh, int wid, int lane) {
    const int r32 = lane & 31, hi = lane >> 5;
    const LAS float* al_l = (const LAS float*)(lds + ATT_WS + wid * 256);
    LAS bf16* Os = (LAS bf16*)(lds + ATT_OST + wid * 4096);
#pragma unroll
    for (int r = 0; r < 16; ++r) { const int row = crow(r, hi); const float inv = al_l[row];
        Os[row * 64 + r32] = (bf16)f2bf((hh ? o[2][r] : o[0][r]) * inv); Os[row * 64 + 32 + r32] = (bf16)f2bf((hh ? o[3][r] : o[1][r]) * inv); }
    LDS_WAIT();
}
__device__ __forceinline__ void build_bias_table(LAS char* lds, const float* rel_bias, int kvh, int tid) {
    LAS float* rb = (LAS float*)(lds + ATT_RB); LAS float* tab = (LAS float*)(lds + ATT_TAB);
    rb[tid] = rel_bias[tid] * LOG2E;
    __syncthreads();
    for (int e = tid; e < 4 * TABN; e += 512) { const int hl = e / TABN, i = e - hl * TABN; int d = i - TAB_NEG; d = d < 0 ? 0 : d;
        tab[e] = rb[rel_bucket_i(d) * NH + kvh * 4 + hl]; }
}
struct RowInfo { const bf16* qp; int dq0, hl; bool valid, active; size_t oidx; };
struct PolPrompt {
    typedef KVPrompt Src;
    const unsigned* LP; const bf16 *Qb, *Kb, *Vb; bf16* PO; float* PL; const LAS int* pref; const LAS int* cnt; int kvh, gsub, ngsub, nitems;
    __device__ __forceinline__ void locate(int k, int& j, int& tile) const { const int it = gsub + k * ngsub; int jj = 0; while (pref[jj + 1] <= it) ++jj; j = jj; tile = it - pref[jj]; }
    __device__ __forceinline__ Src src(int k) const { int j, tile; locate(k, j, tile); return Src{Kb + (size_t)(256 * j) * KVW + kvh * 128, Vb + (size_t)(256 * j) * KVW + kvh * 128}; }
    __device__ __forceinline__ unsigned entry(int k, int wid, int lane) const { int j, tile; locate(k, j, tile); const int idx = tile * 256 + wid * 32 + (lane & 31);
        return idx < cnt[j] ? LP[(size_t)(kvh * 32 + j) * LP_CAP + idx] : 0x80000000u; }
    __device__ __forceinline__ RowInfo rows(int k, unsigned ent, int wid, int lane) const { int j, tile; locate(k, j, tile);
        const int q = ent & 8191, hl = (ent >> 13) & 3, s = (ent >> 15) & 3; RowInfo r; r.valid = !(ent >> 31); r.hl = hl;
        r.qp = Qb + (size_t)q * AW + (kvh * 4 + hl) * 128 + (lane >> 5) * 8; r.dq0 = r.valid ? q - 256 * j : 4096; r.active = wid * 32 < cnt[j] - tile * 256;
        r.oidx = ((size_t)q * NH + kvh * 4 + hl) * 3 + s; return r; }
};
struct PolSample {
    typedef KVPaged Src;
    const unsigned* LS; const bf16* Qb; const float *ck, *cv; const int* pt; bf16* PO; float* PL; const LAS int* items; const LAS int* cnts; int kvh, nitems;
    __device__ __forceinline__ Src src(int k) const { const int si = items[k], b = si >> 5, j = si & 31; return Src{ck + kvh * 128, cv + kvh * 128, pt + b * 64 + 2 * j}; }
    __device__ __forceinline__ unsigned entry(int k, int wid, int lane) const { const int si = items[k], b = si >> 5, j = si & 31, idx = wid * 32 + (lane & 31);
        return idx < cnts[k] ? LS[((size_t)b * 128 + kvh * 32 + j) * 32 + idx] : 0x80000000u; }
    __device__ __forceinline__ RowInfo rows(int k, unsigned ent, int wid, int lane) const { const int si = items[k], b = si >> 5, j = si & 31;
        const int t = ent & 7, hl = (ent >> 3) & 3, s = (ent >> 5) & 3, row = MP + b * 8 + t; RowInfo r; r.valid = !(ent >> 31); r.hl = hl;
        r.qp = Qb + (size_t)row * AW + (kvh * 4 + hl) * 128 + (lane >> 5) * 8; r.dq0 = r.valid ? MP + t - 256 * j : 4096; r.active = wid * 32 < cnts[k];
        r.oidx = ((size_t)row * NH + kvh * 4 + hl) * 3 + s; return r; }
};
struct PolOwn {
    typedef KVPrompt Src;
    const bf16 *Qb, *Kb, *Vb; int kvh, gsub, ngsub, nitems;
    __device__ __forceinline__ Src src(int k) const { const int b = (gsub + k * ngsub) >> 2; return Src{Kb + (size_t)(256 * b) * KVW + kvh * 128, Vb + (size_t)(256 * b) * KVW + kvh * 128}; }
    __device__ __forceinline__ unsigned entry(int, int, int) const { return 0u; }
    __device__ __forceinline__ RowInfo rows(int k, unsigned, int wid, int lane) const { const int it = gsub + k * ngsub, b = it >> 2, hl = it & 3, ql = wid * 32 + (lane & 31);
        RowInfo r; r.valid = true; r.active = true; r.hl = hl; r.dq0 = ql; r.qp = Qb + (size_t)(256 * b + ql) * AW + (kvh * 4 + hl) * 128 + (lane >> 5) * 8; r.oidx = (size_t)it; return r; }
};
template <bool CAUSAL, class Pol, class Fin>
__device__ __forceinline__ void attn_stream(LAS char* lds, const Pol& pol, const Fin& fin, int tid, int wid, int lane) {
    const int n = pol.nitems;
    if (n <= 0) return;
    typename Pol::Src src = pol.src(0); typename Pol::Src::Regs R;
    src.load(0, R, tid);
    unsigned ent_next = pol.entry(0, wid, lane);
    Pol::Src::write(R, lds + ATT_KV, lds + ATT_KV + 16384, tid);
    __syncthreads();
    for (int k = 0; k < n; ++k) {
        const RowInfo ri = pol.rows(k, ent_next, wid, lane);
        bf16x8 qr[8];
#pragma unroll
        for (int d0 = 0; d0 < 8; ++d0) qr[d0] = *(const bf16x8*)(ri.qp + d0 * 16);
        const bool more_items = (k + 1 < n);
        if (more_items) ent_next = pol.entry(k + 1, wid, lane);
        const typename Pol::Src nsrc = more_items ? pol.src(k + 1) : src;
        float m_reg = -1e30f, l_reg = 0.f; f32x16 o[4];
#pragma unroll
        for (int d = 0; d < 4; ++d)
#pragma unroll
            for (int r = 0; r < 16; ++r) o[d][r] = 0.f;
#pragma unroll
        for (int t = 0; t < 4; ++t) {
            LAS char* Kc = lds + ATT_KV + (t & 1) * 32768; LAS char* Kn = lds + ATT_KV + ((t + 1) & 1) * 32768;
            if (t < 3) src.load(t + 1, R, tid); else if (more_items) nsrc.load(0, R, tid);
            if (ri.active && (!CAUSAL || 64 * t <= 32 * wid + 31)) attn_tile<CAUSAL>(lds, Kc, Kc + 16384, qr, ri.dq0 - 64 * t, ri.hl, m_reg, l_reg, o, wid, lane);
            if (t < 3 || more_items) Pol::Src::write(R, Kn, Kn + 16384, tid);
            __syncthreads();
        }
        fin(k, ri, m_reg, l_reg, o);
        src = nsrc;
    }
}
struct FinPartial { LAS char* lds; bf16* PO; float* PL; int wid, lane;
    __device__ __forceinline__ void operator()(int, const RowInfo& ri, float m_reg, float l_reg, const f32x16 (&o)[4]) const {
        if (!ri.active) return;
        put_inv_l(lds, l_reg, wid, lane);
        if (ri.valid && (lane >> 5) == 0) PL[ri.oidx] = m_reg + __builtin_amdgcn_logf(l_reg);
        const int rr = lane >> 1, q2 = lane & 1;
        const int pv = __shfl((int)ri.valid, rr); const unsigned plo = __shfl((unsigned)ri.oidx, rr);
#pragma unroll
        for (int hh = 0; hh < 2; ++hh) {
            stage_o_half(lds, o, hh, wid, lane);
            if (pv) { const LAS v4u* srow = (const LAS v4u*)(lds + ATT_OST + wid * 4096 + rr * 128 + q2 * 64); v4u* dst = (v4u*)(PO + (size_t)plo * 128 + hh * 64 + q2 * 32);
#pragma unroll
                for (int c = 0; c < 4; ++c) dst[c] = srow[c]; }
            LDS_WAIT();
        }
    }
};
struct PgRegs { f32x4 k[8]; f32x4 v[8]; };
__device__ __forceinline__ void pg_load(const float* ck, const float* cv, const int* pt, int t, PgRegs& R, int lt) {
    const int page = pt[t >> 1];
    const size_t o = ((size_t)page * 128 + 64 * (t & 1) + (lt >> 6) * 16 + ((lt >> 5) & 1)) * KVW + 4 * (lt & 31);
#pragma unroll
    for (int i = 0; i < 8; ++i) { R.k[i] = __builtin_nontemporal_load((const f32x4*)(ck + o + (size_t)(2 * i) * KVW)); R.v[i] = __builtin_nontemporal_load((const f32x4*)(cv + o + (size_t)(2 * i) * KVW)); }
}
__device__ __forceinline__ void pg_write(const PgRegs& R, LAS char* Kl, LAS char* Vl, int lt) {
    const int r0 = (lt >> 6) * 16 + ((lt >> 5) & 1), c = 4 * (lt & 31);
#pragma unroll
    for (int i = 0; i < 8; ++i) { const int row = r0 + 2 * i;
        v2u wk; wk.x = cvt_pk_bf16(R.k[i][0], R.k[i][1]); wk.y = cvt_pk_bf16(R.k[i][2], R.k[i][3]);
        v2u wv; wv.x = cvt_pk_bf16(R.v[i][0], R.v[i][1]); wv.y = cvt_pk_bf16(R.v[i][2], R.v[i][3]);
        *(LAS v2u*)(Kl + KSWZ(row, c * 2)) = wk; *(LAS v2u*)(Vl + v_st(row, c)) = wv; }
}
__device__ __forceinline__ void sample_stream(LAS char* lds, const PolSample& pol, const FinPartial& fin, int tid, int wid, int lane) {
    const int n = pol.nitems;
    if (n <= 0) return;
    const int S = 4 * n;
    LAS char* B0 = lds + ATT_KV; LAS char* B1 = lds + ATT_KV + 32768;
    if (wid >= 4) {
        const int lt = tid - 256; PgRegs RA, RB;
        const float* ck = pol.ck + pol.kvh * 128; const float* cv = pol.cv + pol.kvh * 128;
#define SMP_PT(s) (pol.pt + (pol.items[(s) >> 2] >> 5) * 64 + 2 * (pol.items[(s) >> 2] & 31))
        pg_load(ck, cv, SMP_PT(0), 0, RA, lt); pg_load(ck, cv, SMP_PT(1), 1, RB, lt);
        pg_write(RA, B0, B0 + 16384, lt);
        __syncthreads();
        for (int s = 0; s < S; s += 2) {
            if (s + 2 < S) pg_load(ck, cv, SMP_PT(s + 2), (s + 2) & 3, RA, lt);
            pg_write(RB, B1, B1 + 16384, lt);
            __syncthreads();
            if (s + 3 < S) pg_load(ck, cv, SMP_PT(s + 3), (s + 3) & 3, RB, lt);
            if (s + 2 < S) pg_write(RA, B0, B0 + 16384, lt);
            __syncthreads();
        }
#undef SMP_PT
    } else if (wid == 0) {
        __syncthreads();
        unsigned ent_next = pol.entry(0, 0, lane);
        for (int k = 0; k < n; ++k) {
            const RowInfo ri = pol.rows(k, ent_next, 0, lane);
            bf16x8 qr[8];
#pragma unroll
            for (int d0 = 0; d0 < 8; ++d0) qr[d0] = *(const bf16x8*)(ri.qp + d0 * 16);
            if (k + 1 < n) ent_next = pol.entry(k + 1, 0, lane);
            float m_reg = -1e30f, l_reg = 0.f; f32x16 o[4];
#pragma unroll
            for (int d = 0; d < 4; ++d)
#pragma unroll
                for (int r = 0; r < 16; ++r) o[d][r] = 0.f;
#pragma unroll
            for (int t = 0; t < 4; ++t) { LAS char* Kc = (t & 1) ? B1 : B0;
                attn_tile<false>(lds, Kc, Kc + 16384, qr, ri.dq0 - 64 * t, ri.hl, m_reg, l_reg, o, 0, lane);
                __syncthreads(); }
            fin(k, ri, m_reg, l_reg, o);
        }
    } else {
        __syncthreads();
        for (int s = 0; s < S; ++s) __syncthreads();
    }
}

struct FinMerge { LAS char* lds; const bf16* PO; const float* PL; const bf16* GA; bf16* MIX; int kvh, wid, lane;
    __device__ __forceinline__ void operator()(int, const RowInfo& ri, float m_reg, float l_reg, const f32x16 (&o)[4]) const {
        const int it = (int)ri.oidx, b = it >> 2, h = kvh * 4 + (it & 3);
        put_inv_l(lds, l_reg, wid, lane);
        const float lse_own_l = m_reg + __builtin_amdgcn_logf(l_reg);
        const int rr = lane >> 1, q2 = lane & 1, qq = 256 * b + wid * 32 + rr;
        const float lse_own = __shfl(lse_own_l, rr);
        const int nv = b < 3 ? b : 3; const size_t pbase = ((size_t)qq * NH + h) * 3;
        float ls[3], wsl[3]; float M = lse_own;
#pragma unroll
        for (int s = 0; s < 3; ++s) { ls[s] = (s < nv) ? PL[pbase + s] : -1e30f; M = fmaxf(M, ls[s]); }
        const float w_own = __builtin_amdgcn_exp2f(lse_own - M); float W = w_own;
#pragma unroll
        for (int s = 0; s < 3; ++s) { wsl[s] = (s < nv) ? __builtin_amdgcn_exp2f(ls[s] - M) : 0.f; W += wsl[s]; }
        const float invW = 1.0f / W;
#pragma unroll
        for (int hh = 0; hh < 2; ++hh) {
            stage_o_half(lds, o, hh, wid, lane);
            const LAS v4u* srow = (const LAS v4u*)(lds + ATT_OST + wid * 4096 + rr * 128 + q2 * 64);
            const int dcol = h * 128 + hh * 64 + q2 * 32;
            const v4u* ga = (const v4u*)(GA + (size_t)qq * AW + dcol); v4u* dst = (v4u*)(MIX + (size_t)qq * DM + dcol);
#pragma unroll
            for (int c = 0; c < 4; ++c) { const v4u a = srow[c]; float f[8] = {bflo(a.x) * w_own, bfhi(a.x) * w_own, bflo(a.y) * w_own, bfhi(a.y) * w_own, bflo(a.z) * w_own, bfhi(a.z) * w_own, bflo(a.w) * w_own, bfhi(a.w) * w_own};
#pragma unroll
                for (int s = 0; s < 3; ++s) if (s < nv) { const v4u p = *((const v4u*)(PO + (pbase + s) * 128 + hh * 64 + q2 * 32) + c); const float ww = wsl[s];
                    f[0] += ww * bflo(p.x); f[1] += ww * bfhi(p.x); f[2] += ww * bflo(p.y); f[3] += ww * bfhi(p.y); f[4] += ww * bflo(p.z); f[5] += ww * bfhi(p.z); f[6] += ww * bflo(p.w); f[7] += ww * bfhi(p.w); }
                const v4u g = ga[c]; v4u w;
                w.x = cvt_pk_bf16(f[0] * invW * bflo(g.x), f[1] * invW * bfhi(g.x)); w.y = cvt_pk_bf16(f[2] * invW * bflo(g.y), f[3] * invW * bfhi(g.y));
                w.z = cvt_pk_bf16(f[4] * invW * bflo(g.z), f[5] * invW * bfhi(g.z)); w.w = cvt_pk_bf16(f[6] * invW * bflo(g.w), f[7] * invW * bfhi(g.w));
                dst[c] = w; }
            LDS_WAIT();
        }
    }
};
template <int W> __device__ __forceinline__ void pool_task(const bf16* Ub, const float* state_pool, bf16* ZP, int rb, int col) {
    constexpr int NX = 8 + W - 1;
    v4u x[NX];
    const bool smp = rb >= MP / 8; const int r0 = rb * 8, b = rb - MP / 8;
#pragma unroll
    for (int i = 0; i < NX; ++i) { const int off = i - (W - 1);
        if (!smp) { x[i] = (r0 + off >= 0) ? *(const v4u*)(Ub + (size_t)(r0 + off) * PW + col) : (v4u){0u, 0u, 0u, 0u}; }
        else if (off >= 0) x[i] = *(const v4u*)(Ub + (size_t)(r0 + off) * PW + col);
        else { const float* sp = state_pool + (size_t)(b * 15 + 15 + off) * PW + col; const f32x4 a = *(const f32x4*)sp, c = *(const f32x4*)(sp + 4);
            x[i].x = cvt_pk_bf16(a.x, a.y); x[i].y = cvt_pk_bf16(a.z, a.w); x[i].z = cvt_pk_bf16(c.x, c.y); x[i].w = cvt_pk_bf16(c.z, c.w); } }
    float s[8];
#pragma unroll
    for (int e = 0; e < 8; ++e) s[e] = 0.f;
#pragma unroll
    for (int i = 0; i < W - 1; ++i) { s[0] += bflo(x[i].x); s[1] += bfhi(x[i].x); s[2] += bflo(x[i].y); s[3] += bfhi(x[i].y); s[4] += bflo(x[i].z); s[5] += bfhi(x[i].z); s[6] += bflo(x[i].w); s[7] += bfhi(x[i].w); }
#pragma unroll
    for (int k = 0; k < 8; ++k) { const v4u c = x[k + W - 1], old = x[k];
        const float u[8] = {bflo(c.x), bfhi(c.x), bflo(c.y), bfhi(c.y), bflo(c.z), bfhi(c.z), bflo(c.w), bfhi(c.w)};
#pragma unroll
        for (int e = 0; e < 8; ++e) s[e] += u[e];
        const int cnt = smp ? W : ((r0 + k + 1) < W ? (r0 + k + 1) : W); const float inv = 1.0f / (float)cnt;
        v4u ov; ov.x = cvt_pk_bf16(s[0] * inv - u[0], s[1] * inv - u[1]); ov.y = cvt_pk_bf16(s[2] * inv - u[2], s[3] * inv - u[3]);
        ov.z = cvt_pk_bf16(s[4] * inv - u[4], s[5] * inv - u[5]); ov.w = cvt_pk_bf16(s[6] * inv - u[6], s[7] * inv - u[7]);
        *(v4u*)(ZP + (size_t)(r0 + k) * PW + col) = ov;
        s[0] -= bflo(old.x); s[1] -= bfhi(old.x); s[2] -= bflo(old.y); s[3] -= bfhi(old.y); s[4] -= bflo(old.z); s[5] -= bfhi(old.z); s[6] -= bflo(old.w); s[7] -= bfhi(old.w); }
}


__device__ __forceinline__ void cmean_item(const float* cache_k, const int* page_table, float* CMEAN, LAS unsigned char* lds, int it, int tid) {
    LAS f32x4* red = (LAS f32x4*)lds;
    const int c4 = tid & 127, rg = tid >> 7, b = it >> 5, j = it & 31;
    f32x4 acc = (f32x4){0.f, 0.f, 0.f, 0.f};
    const int page0 = page_table[b * 64 + 2 * j], page1 = page_table[b * 64 + 2 * j + 1];
#pragma unroll
    for (int hpg = 0; hpg < 2; ++hpg) {
        const float* base = cache_k + ((size_t)(hpg ? page1 : page0) * 128 + rg) * KVW + c4 * 4;
        f32x4 v[32];
#pragma unroll
        for (int rr = 0; rr < 32; ++rr) v[rr] = __builtin_nontemporal_load((const f32x4*)(base + (size_t)(4 * rr) * KVW));
#pragma unroll
        for (int rr = 0; rr < 32; ++rr) acc += v[rr];
    }
    red[rg * 128 + c4] = acc;
    __syncthreads();
    if (rg == 0) { const f32x4 s = (red[c4] + red[128 + c4]) + (red[256 + c4] + red[384 + c4]); *(f32x4*)(CMEAN + (size_t)it * KVW + c4 * 4) = s * (1.0f / 256.0f); }
    __syncthreads();
}

__global__ void __launch_bounds__(512, 2) moba_fwd(Params P) {
    extern __shared__ __attribute__((aligned(16))) unsigned char lds_raw[];
    LAS unsigned char* lds = (LAS unsigned char*)lds_raw;
    LAS char* ldc = (LAS char*)lds_raw;
    const int tid = threadIdx.x, lane = tid & 63, wid = __builtin_amdgcn_readfirstlane(tid >> 6);
    const int G = gridDim.x, bid = blockIdx.x;
    unsigned char* ws = P.ws;
    unsigned* ctl = (unsigned*)(ws + WS_CTL);
    bf16* WinT = (bf16*)(ws + WS_WIN); bf16* WoutT = (bf16*)(ws + WS_WOUT); bf16* WpT = (bf16*)(ws + WS_WP); bf16* XN = (bf16*)(ws + WS_XN);
    bf16* Qb = (bf16*)(ws + WS_Q); bf16* GA = (bf16*)(ws + WS_GA); bf16* Ub = (bf16*)(ws + WS_U); bf16* GP = (bf16*)(ws + WS_GP); bf16* ZP = (bf16*)(ws + WS_ZP);
    bf16* Kb = (bf16*)(ws + WS_K); bf16* Vb = (bf16*)(ws + WS_V); bf16* MIX = (bf16*)(ws + WS_MIX);
    float* CMEAN = (float*)(ws + WS_CMEAN); unsigned* LP = (unsigned*)(ws + WS_LP); unsigned* LS = (unsigned*)(ws + WS_LS);
    bf16* PO = (bf16*)(ws + WS_PO); float* PL = (float*)(ws + WS_PL); float* SSQ = (float*)(ws + WS_SSQ); float* SLAB = (float*)(ws + WS_SLAB);
    float* KMS = (float*)(ctl + CW_KMS); unsigned* cntP = ctl + CW_CNTP; unsigned* cntS = ctl + CW_CNTS;

    for (int u = tid; u < (LDS_BYTES - LDSCTL_OFF) / 4; u += 512) ((LAS unsigned*)(lds + LDSCTL_OFF))[u] = 0u;
    __syncthreads();
    volatile LAS unsigned* MISC = (volatile LAS unsigned*)(lds + LDSCTL_OFF + 320);
    const int lo = P.ph_lo, hi_ph = P.ph_hi;
    XcdBarrier bar; bar.bar = ctl + CW_BAR; bar.x = 0; bar.st = nullptr;
    if (MK_N_LAUNCHES == 1) bar = xcd_barrier_post(ctl + CW_BAR + P.li * XCD_BAR_WORDS, MISC + 8);
#define IN(k) (lo <= (k) && (k) < hi_ph)
#define SEAM(k) do { if (MK_N_LAUNCHES == 1 && IN(k) && IN((k) + 1)) xcd_barrier(bar); } while (0)

    if (IN(0)) {
        LAS float* scr = (LAS float*)(lds + wid * 16384);
        const int gw = bid * 8 + wid, NGW = G * 8;
        constexpr int I_IN = (DM / 64) * (NIN / 32), I_OUT = (DM / 64) * (DM / 32), I_PG = (512 / 64) * (512 / 32);
        for (int it = gw; it < I_IN + I_OUT + 4 * I_PG; it += NGW) {
            int r = it;
            if (r < I_IN) { p0_transpose_item(P.w_in, DM, NIN, WinT, scr, r, lane); continue; } r -= I_IN;
            if (r < I_OUT) { p0_transpose_item(P.w_out, DM, DM, WoutT, scr, r, lane); continue; } r -= I_OUT;
            const int g = r / I_PG; p0_transpose_item(P.w_pool + (size_t)g * 512 * 512, 512, 512, WpT + (size_t)g * 512 * 512, scr, r - g * I_PG, lane);
        }
        for (int m = gw; m < MT; m += NGW) rms_row_to_bf16(m < MP ? P.x_p + (size_t)m * DM : P.x_s + (size_t)(m - MP) * DM, P.norm_in, XN + (size_t)m * DM, lane);
        __syncthreads();
        for (int it = bid; it < CM_SPLIT; it += G) cmean_item(P.cache_k, P.page_table, CMEAN, lds, it, tid);
    }
    SEAM(0);

    if (IN(1)) {
        pg8::Gemm g{XN, WinT, MT, NIN, DM, DM, DM, 0, 0, 0x7fffffff, 0}; pg8::StaticOrder S; S.init(MT, NIN, G, bid);
        EpiIn E{Qb, Kb, Vb, GA, Ub, GP, P.out, KMS};
        pg8::gemm_phase<EpiIn>(lds, g, S, E);
        const int nunits = (MT / 256) * (NIN / 256), nshort = G - (nunits % G);
        if (nunits % G != 0 && bid >= nunits % G) { for (int it = CM_SPLIT + (bid - nunits % G); it < 1024; it += nshort) cmean_item(P.cache_k, P.page_table, CMEAN, lds, it, tid); }
        else if (nunits % G == 0) { for (int it = CM_SPLIT + bid; it < 1024; it += G) cmean_item(P.cache_k, P.page_table, CMEAN, lds, it, tid); }
    }
    SEAM(1);

    if (IN(2)) {
        LAS float* KM = (LAS float*)lds;
        LAS int* cntL = (LAS int*)(lds + 65536); LAS int* baseL = cntL + 128; LAS int* SELL = baseL + 128; LAS int* LPL = SELL + 32 * 48;
        const int h = lane >> 2, part = lane & 3, kvh = h >> 2;
        for (int ch = bid; ch < 256 + 32; ch += G) {
            const bool smp = ch >= 256; const int b_s = ch - 256;
            const int nblk = smp ? 32 : (ch >> 3);
            const int nvalid = nblk < 3 ? nblk : 3;
            __syncthreads();
            if (smp) { for (int e = tid; e < 32 * 128; e += 512) ((LAS f32x4*)KM)[e] = *(const f32x4*)(CMEAN + (size_t)b_s * 32 * KVW + e * 4); }
            else { for (int e = tid; e < nblk * 128; e += 512) ((LAS f32x4*)KM)[e] = *(const f32x4*)(KMS + e * 4) * (1.0f / 256.0f); }
            if (tid < 128) cntL[tid] = 0;
            __syncthreads();
            const int nrow = smp ? 1 : 4;
            for (int i = 0; i < nrow; ++i) {
                const int rl = smp ? wid : wid * 4 + i;
                const int r = smp ? MP + b_s * 8 + wid : ch * 32 + rl;
                float q[32];
                { const v4u* qp = (const v4u*)(Qb + (size_t)r * AW + h * 128 + part * 32);
#pragma unroll
                  for (int c = 0; c < 4; ++c) { const v4u w = qp[c]; q[8 * c + 0] = bflo(w.x); q[8 * c + 1] = bfhi(w.x); q[8 * c + 2] = bflo(w.y); q[8 * c + 3] = bfhi(w.y);
                      q[8 * c + 4] = bflo(w.z); q[8 * c + 5] = bfhi(w.z); q[8 * c + 6] = bflo(w.w); q[8 * c + 7] = bfhi(w.w); } }
                float v0 = -3.0e38f, v1 = -3.0e38f, v2 = -3.0e38f; int i0 = 0, i1 = 0, i2 = 0;
                for (int n = 0; n < nblk; ++n) {
                    const LAS f32x4* km = (const LAS f32x4*)(KM + n * KVW + kvh * 128 + part * 32);
                    float a = 0.f;
#pragma unroll
                    for (int c = 0; c < 8; ++c) { const f32x4 k4 = km[c]; a = fmaf(q[4 * c], k4.x, a); a = fmaf(q[4 * c + 1], k4.y, a); a = fmaf(q[4 * c + 2], k4.z, a); a = fmaf(q[4 * c + 3], k4.w, a); }
                    a += __shfl_xor(a, 1); a += __shfl_xor(a, 2);
                    if (a > v0) { v2 = v1; i2 = i1; v1 = v0; i1 = i0; v0 = a; i0 = n; }
                    else if (a > v1) { v2 = v1; i2 = i1; v1 = a; i1 = n; }
                    else if (a > v2) { v2 = a; i2 = n; }
                }
                if (part == 0) {
                    const int e0 = (rl * 16 + h) * 3;
                    if (nvalid > 0) { SELL[e0] = i0; LPL[e0] = __hip_atomic_fetch_add(&cntL[kvh * 32 + i0], 1, __ATOMIC_RELAXED, __HIP_MEMORY_SCOPE_WORKGROUP); }
                    if (nvalid > 1) { SELL[e0 + 1] = i1; LPL[e0 + 1] = __hip_atomic_fetch_add(&cntL[kvh * 32 + i1], 1, __ATOMIC_RELAXED, __HIP_MEMORY_SCOPE_WORKGROUP); }
                    if (nvalid > 2) { SELL[e0 + 2] = i2; LPL[e0 + 2] = __hip_atomic_fetch_add(&cntL[kvh * 32 + i2], 1, __ATOMIC_RELAXED, __HIP_MEMORY_SCOPE_WORKGROUP); }
                }
            }
            __syncthreads();
            if (tid < 128) { const int c = cntL[tid];
                if (smp) { baseL[tid] = 0; cntS[b_s * 128 + tid] = (unsigned)c; }
                else baseL[tid] = c ? (int)__hip_atomic_fetch_add(cntP + tid, (unsigned)c, __ATOMIC_RELAXED, __HIP_MEMORY_SCOPE_AGENT) : 0; }
            __syncthreads();
            const int nent = (smp ? 8 : 32) * 48;
            for (int e = tid; e < nent; e += 512) { const int s = e % 3; if (s >= nvalid) continue;
                const int hh = (e / 3) & 15, rl = e / 48, j = SELL[e], lp = LPL[e], li = (hh >> 2) * 32 + j;
                if (smp) LS[((size_t)b_s * 128 + li) * 32 + lp] = (unsigned)(rl | ((hh & 3) << 3) | (s << 5));
                else LP[(size_t)li * LP_CAP + baseL[li] + lp] = (unsigned)((ch * 32 + rl) | ((hh & 3) << 13) | (s << 15)); }
        }
        for (int task = bid * 512 + tid; task < (MT / 8) * 256; task += G * 512) {
            const int rb = task >> 8, col = (task & 255) * 8;
            switch (col >> 9) { case 0: pool_task<2>(Ub, P.state_pool, ZP, rb, col); break; case 1: pool_task<4>(Ub, P.state_pool, ZP, rb, col); break;
                                case 2: pool_task<8>(Ub, P.state_pool, ZP, rb, col); break; default: pool_task<16>(Ub, P.state_pool, ZP, rb, col); break; }
        }
        for (int e = bid * 512 + tid; e < 32 * 7 * (PW / 4); e += G * 512) { const int c4 = e % (PW / 4), rr = (e / (PW / 4)) % 7, b = e / (7 * (PW / 4));
            *(f32x4*)(P.out + O_PS + (size_t)(b * 15 + rr) * PW + c4 * 4) = *(const f32x4*)(P.state_pool + (size_t)(b * 15 + 8 + rr) * PW + c4 * 4); }
    }
    SEAM(2);

    if (IN(3)) {
        {
            pg8::Gemm g{ZP, WpT, MT, PW, 512, PW, 512, 1, 512, 0x7fffffff, 0}; pg8::StaticOrder S; S.init(MT, PW, G, bid);
            EpiPool E{GP, P.pool_scale, MIX};
            pg8::gemm_phase<EpiPool>(lds, g, S, E);
        }
        const int kvh = bid & 3, gsub = bid >> 2, ngsub = G >> 2;
        __syncthreads();
        build_bias_table(ldc, P.rel_bias, kvh, tid);
        LAS int* pref = (LAS int*)(lds + ATT_MISC); LAS int* cntl = pref + 40; LAS int* sitems = cntl + 32; LAS int* scnts = sitems + 24; LAS int* nsi = scnts + 24;
        if (tid == 0) { int a = 0; for (int j = 0; j < 32; ++j) { const int c = (int)cntP[kvh * 32 + j]; cntl[j] = c; pref[j] = a; a += (c + 255) >> 8; } pref[32] = a;
            int ns = 0; for (int si = gsub; si < 1024; si += ngsub) { const int c = (int)cntS[(si >> 5) * 128 + kvh * 32 + (si & 31)]; if (c > 0) { sitems[ns] = si; scnts[ns] = c; ++ns; } } *nsi = ns; }
        __syncthreads();
        {
            const int npi = pref[32];
            const PolPrompt polp{LP, Qb, Kb, Vb, PO, PL, pref, cntl, kvh, gsub, ngsub, npi > gsub ? (npi - gsub + ngsub - 1) / ngsub : 0};
            const PolSample pols{LS, Qb, P.cache_k, P.cache_v, P.page_table, PO, PL, sitems, scnts, kvh, *nsi};
            const FinPartial fin{ldc, PO, PL, wid, lane};
            const int first_sample = (bid >> 2) & 1;
            if (first_sample) {
                sample_stream(ldc, pols, fin, tid, wid, lane);
                __syncthreads();
                attn_stream<false, PolPrompt, FinPartial>(ldc, polp, fin, tid, wid, lane);
            } else {
                attn_stream<false, PolPrompt, FinPartial>(ldc, polp, fin, tid, wid, lane);
                __syncthreads();
                sample_stream(ldc, pols, fin, tid, wid, lane);
            }
        }
    }
    SEAM(3);

    if (IN(4)) {
        const int kvh = bid & 3, gsub = bid >> 2, ngsub = G >> 2;
        __syncthreads();
        build_bias_table(ldc, P.rel_bias, kvh, tid);
        __syncthreads();
        {
            PolOwn pol{Qb, Kb, Vb, kvh, gsub, ngsub, 128 > gsub ? (128 - gsub + ngsub - 1) / ngsub : 0};
            FinMerge fin{ldc, PO, PL, GA, MIX, kvh, wid, lane};
            attn_stream<true, PolOwn, FinMerge>(ldc, pol, fin, tid, wid, lane);
        }
        for (int task = bid * 8 + wid; task < MS * NH; task += G * 8) {
            const int h = task & 15, rs = task >> 4, b = rs >> 3, t = rs & 7, row = MP + rs, kv = h >> 2;
            const unsigned qw = *(const unsigned*)(Qb + (size_t)row * AW + h * 128 + 2 * lane); const float q0 = bflo(qw), q1 = bfhi(qw);
            float x[8], vx[8], vy[8]; const size_t pbase = ((size_t)row * NH + h) * 3;
            float M = fmaxf(fmaxf(PL[pbase], PL[pbase + 1]), PL[pbase + 2]);
#pragma unroll
            for (int tp = 0; tp < 8; ++tp) { x[tp] = -1e30f; vx[tp] = 0.f; vy[tp] = 0.f;
                if (tp <= t) { const size_t ko = (size_t)(MP + b * 8 + tp) * KVW + kv * 128 + 2 * lane; const unsigned kw = *(const unsigned*)(Kb + ko), vw = *(const unsigned*)(Vb + ko);
                    x[tp] = wave_sum(q0 * bflo(kw) + q1 * bfhi(kw)) * C_SC + P.rel_bias[(t - tp) * NH + h] * LOG2E; vx[tp] = bflo(vw); vy[tp] = bfhi(vw); M = fmaxf(M, x[tp]); } }
            float W = 0.f, a0 = 0.f, a1 = 0.f;
#pragma unroll
            for (int tp = 0; tp < 8; ++tp) { const float w = (tp <= t) ? __builtin_amdgcn_exp2f(x[tp] - M) : 0.f; W += w; a0 += w * vx[tp]; a1 += w * vy[tp]; }
#pragma unroll
            for (int s = 0; s < 3; ++s) { const float w = __builtin_amdgcn_exp2f(PL[pbase + s] - M); const unsigned pw = *(const unsigned*)(PO + (pbase + s) * 128 + 2 * lane); W += w; a0 += w * bflo(pw); a1 += w * bfhi(pw); }
            const unsigned gw = *(const unsigned*)(GA + (size_t)row * AW + h * 128 + 2 * lane); const float inv = 1.0f / W;
            *(unsigned*)(MIX + (size_t)row * DM + h * 128 + 2 * lane) = cvt_pk_bf16(a0 * inv * bflo(gw), a1 * inv * bfhi(gw));
        }
    }
    SEAM(4);

    if (IN(5)) {
        {
            pg8::Gemm g{MIX, WoutT, MP, DM, DM, DM, DM, 0, 0, 0x7fffffff, 0}; pg8::StaticOrder S; S.init(MP, DM, G, bid);
            EpiOut E{P.x_p, P.x_s, P.out + O_Y, SSQ};
            pg8::gemm_phase<EpiOut>(lds, g, S, E);
        }
        {
            pg8::Gemm g{MIX + (size_t)MP * DM, WoutT, MS, 128 * 256, 512, DM, DM, 4, 512, 15, 512}; pg8::StaticOrder S; S.init(MS, 128 * 256, G, bid);
            EpiSlab E{SLAB};
            pg8::gemm_phase<EpiSlab>(lds, g, S, E);
        }
    }
    SEAM(5);

    if (IN(6)) {
        const int gw = bid * 8 + wid, NGW = G * 8;
        if (gw < MS) {
            const int m = gw; f32x4 v[16]; float ss = 0.f;
            const f32x4* xr = (const f32x4*)(P.x_s + (size_t)m * DM) + lane;
#pragma unroll
            for (int j = 0; j < 16; ++j) v[j] = xr[64 * j];
#pragma unroll
            for (int ks = 0; ks < 8; ++ks) { const f32x4* sr = (const f32x4*)(SLAB + ((size_t)ks * MS + m) * DM) + lane;
#pragma unroll
                for (int j = 0; j < 16; ++j) v[j] += sr[64 * j]; }
#pragma unroll
            for (int j = 0; j < 16; ++j) ss += (v[j].x * v[j].x + v[j].y * v[j].y) + (v[j].z * v[j].z + v[j].w * v[j].w);
            const float rstd = 1.0f / sqrtf(wave_sum(ss) * (1.f / DM) + RMS_EPS);
            f32x4* y = (f32x4*)(P.out + O_Y + (size_t)(MP + m) * DM) + lane; const f32x4* gn = (const f32x4*)P.norm_out + lane;
#pragma unroll
            for (int j = 0; j < 16; ++j) { const f32x4 g = gn[64 * j]; f32x4 o = v[j]; o.x *= rstd * g.x; o.y *= rstd * g.y; o.z *= rstd * g.z; o.w *= rstd * g.w; y[64 * j] = o; }
        }
        for (int m = NGW - 1 - gw; m < MP; m += NGW) {
            const float ss = wave_sum(SSQ[(size_t)m * 64 + lane]);
            const float rstd = 1.0f / sqrtf(ss * (1.f / DM) + RMS_EPS);
            f32x4* y = (f32x4*)(P.out + O_Y + (size_t)m * DM) + lane; const f32x4* gn = (const f32x4*)P.norm_out + lane;
#pragma unroll
            for (int j = 0; j < 16; ++j) { const f32x4 g = gn[64 * j]; f32x4 v = y[64 * j]; v.x *= rstd * g.x; v.y *= rstd * g.y; v.z *= rstd * g.z; v.w *= rstd * g.w; y[64 * j] = v; }
        }
    }
#undef IN
#undef SEAM
}

extern "C" void kernel_launch(void* const* d_in, const int* in_sizes, int n_in, void* d_out, int out_size, void* d_ws, size_t ws_size, hipStream_t stream) {
    static int grid = 0;
    if (grid == 0) {
        if (n_in != 13 || (size_t)out_size != O_END || ws_size < WS_END) { fprintf(stderr, "kernel_launch: unexpected shapes (n_in %d out %d ws %zu)\n", n_in, out_size, ws_size); grid = -1; return; }
        int dev = 0, cus = 0, per_cu = 0;
        if (hipGetDevice(&dev) != hipSuccess || hipDeviceGetAttribute(&cus, hipDeviceAttributeMultiprocessorCount, dev) != hipSuccess) { grid = -1; return; }
        if (hipFuncSetAttribute((const void*)moba_fwd, hipFuncAttributeMaxDynamicSharedMemorySize, LDS_BYTES) != hipSuccess) { fprintf(stderr, "kernel_launch: hipFuncSetAttribute failed\n"); grid = -1; return; }
        if (hipOccupancyMaxActiveBlocksPerMultiprocessor(&per_cu, (const void*)moba_fwd, 512, LDS_BYTES) != hipSuccess || per_cu < 1) fprintf(stderr, "kernel_launch: occupancy query reports %d\n", per_cu);
        (void)hipGetLastError();
        grid = cus;
        if (grid % 4 != 0) { fprintf(stderr, "kernel_launch: grid %d not a multiple of 4\n", grid); grid = -1; return; }
    }
    if (grid < 0) return;
    (void)hipMemsetAsync((char*)d_ws + WS_CTL, 0, CTL_ZERO_BYTES, stream);
    Params p{};
    p.x_p = (const float*)d_in[0]; p.x_s = (const float*)d_in[1]; p.cache_k = (const float*)d_in[2]; p.cache_v = (const float*)d_in[3]; p.state_pool = (const float*)d_in[4];
    p.page_table = (const int*)d_in[5]; p.norm_in = (const float*)d_in[6]; p.w_in = (const float*)d_in[7]; p.w_pool = (const float*)d_in[8]; p.pool_scale = (const float*)d_in[9];
    p.w_out = (const float*)d_in[10]; p.rel_bias = (const float*)d_in[11]; p.norm_out = (const float*)d_in[12];
    p.out = (float*)d_out; p.ws = (unsigned char*)d_ws;
#if MK_N_LAUNCHES == 1 && PROBE_REP >= 0
    p.ph_lo = 0; p.ph_hi = (PROBE_REP == 55) ? 6 : (PROBE_REP == 5 || PROBE_REP == 6) ? 7 : PROBE_REP + 1; p.li = 0;
    hipLaunchKernelGGL(moba_fwd, dim3(grid), dim3(512), LDS_BYTES, stream, p);
#if PROBE_REP == 1
    (void)hipMemsetAsync((char*)d_ws + WS_CTL + CW_KMS * 4, 0, 32 * 512 * 4, stream);
#elif PROBE_REP == 2
    (void)hipMemsetAsync((char*)d_ws + WS_CTL + CW_CNTP * 4, 0, (CW_KMS - CW_CNTP) * 4, stream);
#endif
    p.ph_lo = (PROBE_REP == 55) ? 5 : PROBE_REP; p.ph_hi = 7; p.li = 1;
    hipLaunchKernelGGL(moba_fwd, dim3(grid), dim3(512), LDS_BYTES, stream, p);
#elif MK_N_LAUNCHES == 1
    p.ph_lo = 0; p.ph_hi = 7;
    hipLaunchKernelGGL(moba_fwd, dim3(grid), dim3(512), LDS_BYTES, stream, p);
#else
    for (int ph = 0; ph < 7; ++ph) { p.ph_lo = ph; p.ph_hi = ph + 1; hipLaunchKernelGGL(moba_fwd, dim3(grid), dim3(512), LDS_BYTES, stream, p); }
#endif
}
```
